# Optimizing an MI355X kernel written in HIP

```python
import jax, jax.numpy as jnp
from jax import lax
import numpy as np

D_MODEL = 1024
BATCH = 2
SEQ = 8192
DEPTH = 2

GRID_W = 64
CTX_LEN = 256
N_MOD = 6
EPS = 1e-6
N_EVEN = (DEPTH + 1) // 2
N_ODD = DEPTH // 2
MLA_HEADS = 8
MLA_NOPE = 64
MLA_ROPE = 32
MLA_V = 64
MLA_Q_RANK = 256
MLA_KV_RANK = 128
MLA_SCALE = (MLA_NOPE + MLA_ROPE) ** -0.5
CONV_CH = 512
CONV_WIDTH = 31
AB_IN = MLA_Q_RANK + MLA_KV_RANK + MLA_ROPE + 2 * CONV_CH
AB_MIX = MLA_HEADS * MLA_V + CONV_CH
ROPE_BASE = 10000.0
Q_BLOCK = 128
HG_HEADS = 8
HG_DK = 128
HG_DV = D_MODEL // HG_HEADS
HG_F = HG_HEADS * HG_DK
HG_V = HG_HEADS * HG_DV
HG_IN = 3 * HG_F + 2 * HG_V
HG_CHUNK = 64
PEER_HEADS = 8
PEER_NKEYS = 128
PEER_EXPERTS = PEER_NKEYS * PEER_NKEYS
PEER_QDIM = 256
PEER_HALF = PEER_QDIM // 2
PEER_TOPK = 16
PEER_BLOCK = 128

kernel_name = 'hybrid_mla_conformer_hgrn2_peer_block'


def rms_norm(x, g):
    xf = x.astype(jnp.float32)
    y = xf * lax.rsqrt(jnp.mean(xf * xf, axis=-1, keepdims=True) + EPS)
    return (y * g.astype(jnp.float32)).astype(x.dtype)


def layer_norm(x, g, b):
    xf = x.astype(jnp.float32)
    mu = jnp.mean(xf, axis=-1, keepdims=True)
    xc = xf - mu
    y = xc * lax.rsqrt(jnp.mean(xc * xc, axis=-1, keepdims=True) + EPS)
    return (y * g.astype(jnp.float32) + b.astype(jnp.float32)).astype(x.dtype)


def modulate(h, shift, scale):
    return h * (1 + scale) + shift


def axial_rope_tables(n_tokens):
    rows = n_tokens // GRID_W
    row = jnp.repeat(jnp.arange(rows, dtype=jnp.float32), GRID_W)
    col = jnp.tile(jnp.arange(GRID_W, dtype=jnp.float32), rows)
    axis_dim = MLA_ROPE // 2
    inv = ROPE_BASE ** (-jnp.arange(0, axis_dim, 2, dtype=jnp.float32) / axis_dim)
    ang = jnp.concatenate([row[:, None] * inv, col[:, None] * inv], axis=-1)
    return jnp.cos(ang), jnp.sin(ang)


def apply_rope(x, cos, sin):
    xp = x.astype(jnp.float32).reshape(x.shape[:-1] + (x.shape[-1] // 2, 2))
    x0, x1 = xp[..., 0], xp[..., 1]
    out = jnp.stack([x0 * cos - x1 * sin, x0 * sin + x1 * cos], axis=-1)
    return out.reshape(x.shape).astype(x.dtype)


def mla_queries(cq, q_g, w_uq):
    B, T = cq.shape[:2]
    return (rms_norm(cq, q_g) @ w_uq).reshape(B, T, MLA_HEADS, MLA_NOPE + MLA_ROPE)


def mla_keys_values(ckv, k_rope, kv_g, w_ukv):
    B, T = ckv.shape[:2]
    kv = (rms_norm(ckv, kv_g) @ w_ukv).reshape(B, T, MLA_HEADS, MLA_NOPE + MLA_V)
    k = jnp.concatenate([kv[..., :MLA_NOPE], jnp.broadcast_to(k_rope[:, :, None, :], (B, T, MLA_HEADS, MLA_ROPE))], axis=-1)
    return k, kv[..., MLA_NOPE:]


def attend(q, k, v):
    s = jnp.einsum('bqhd,bkhd->bhqk', q, k).astype(jnp.float32) * MLA_SCALE
    p = jax.nn.softmax(s, axis=-1).astype(v.dtype)
    return jnp.einsum('bhqk,bkhd->bqhd', p, v)


def blocked_attention(q, k, v):
    B, T, H, dq = q.shape
    nb = T // Q_BLOCK
    qb = q.reshape(B, nb, Q_BLOCK, H, dq).transpose(1, 0, 2, 3, 4)
    ob = lax.map(lambda qi: attend(qi, k, v), qb)
    return ob.transpose(1, 0, 2, 3, 4).reshape(B, T, H, v.shape[-1])


def conformer_conv(u, conv_w, conv_b, ln_g, ln_b):
    a, gt = jnp.split(u, 2, axis=-1)
    y = a * jax.nn.sigmoid(gt)
    y = lax.conv_general_dilated(y, conv_w[:, None, :], window_strides=(1,),
                                 padding=[(CONV_WIDTH // 2, CONV_WIDTH // 2)],
                                 dimension_numbers=('NWC', 'WIO', 'NWC'),
                                 feature_group_count=CONV_CH) + conv_b
    return jax.nn.silu(layer_norm(y, ln_g, ln_b))


def mla_conv_mixer(h, hc, need_ctx_out, w_in, q_g, w_uq, kv_g, w_ukv, conv_w, conv_b, ln_g, ln_b, w_out):
    B, T = h.shape[:2]
    splits = [MLA_Q_RANK, MLA_Q_RANK + MLA_KV_RANK, MLA_Q_RANK + MLA_KV_RANK + MLA_ROPE]
    cq, ckv, kr, cu = jnp.split(h @ w_in, splits, axis=-1)
    cqc, ckvc, krc, cuc = jnp.split(hc @ w_in, splits, axis=-1)
    cos, sin = axial_rope_tables(T)
    q = mla_queries(cq, q_g, w_uq)
    q = jnp.concatenate([q[..., :MLA_NOPE], apply_rope(q[..., MLA_NOPE:], cos[:, None], sin[:, None])], axis=-1)
    k, v = mla_keys_values(ckv, apply_rope(kr, cos, sin), kv_g, w_ukv)
    kc, vc = mla_keys_values(ckvc, krc, kv_g, w_ukv)
    o = blocked_attention(q, jnp.concatenate([kc, k], axis=1), jnp.concatenate([vc, v], axis=1))
    y = jnp.concatenate([o.reshape(B, T, -1), conformer_conv(cu, conv_w, conv_b, ln_g, ln_b)], axis=-1) @ w_out
    if not need_ctx_out:
        return y, None
    oc = attend(mla_queries(cqc, q_g, w_uq), kc, vc)
    yc = jnp.concatenate([oc.reshape(B, hc.shape[1], -1), conformer_conv(cuc, conv_w, conv_b, ln_g, ln_b)], axis=-1) @ w_out
    return y, yc


def hgrn_lower_bounds(lb_param):
    p = jax.nn.softmax(lb_param.astype(jnp.float32), axis=0)
    cum = jnp.cumsum(p, axis=0)
    return cum - cum[0]


def gla_chunked(q, k, v, logf, s0):
    B, T, H, DK = q.shape
    DV = v.shape[-1]
    C = HG_CHUNK
    n = T // C
    q, k, v, logf = [a.reshape(B, n, C, H, a.shape[-1]) for a in (q, k, v, logf)]
    b = jnp.cumsum(logf, axis=2)
    b_last = b[:, :, -1:]
    q_in = q * jnp.exp(b)
    k_in = k * jnp.exp(-b)
    k_out = k * jnp.exp(b_last - b)
    mask = jnp.tril(jnp.ones((C, C), dtype=bool))
    a = jnp.where(mask, jnp.einsum('bnthk,bnshk->bnhts', q_in, k_in), 0.0)
    o_intra = jnp.einsum('bnhts,bnshv->bnthv', a, v)
    ds = jnp.einsum('bnshk,bnshv->bnhkv', k_out, v)
    decay = jnp.exp(b_last[:, :, 0])

    def step(s, inp):
        d, dsn = inp
        return d[..., None] * s + dsn, s

    s_final, s_prev = lax.scan(step, s0, (jnp.moveaxis(decay, 1, 0), jnp.moveaxis(ds, 1, 0)))
    s_prev = jnp.moveaxis(s_prev, 0, 1)
    o_inter = jnp.einsum('bnthk,bnhkv->bnthv', q_in, s_prev)
    return (o_intra + o_inter).reshape(B, T, H, DV), s_final


def hgrn_mixer(h, hc, layer_idx, need_ctx_out, w_in, lb_param, norm_g, w_out):
    lb = hgrn_lower_bounds(lb_param)[layer_idx]

    def heads(a, d):
        return a.reshape(a.shape[:2] + (HG_HEADS, d))

    def prep(hh):
        p = (hh @ w_in).astype(jnp.float32)
        q, zf, zb, i, g = jnp.split(p, [HG_F, 2 * HG_F, 3 * HG_F, 3 * HG_F + HG_V], axis=-1)
        ff = lb[0] + (1.0 - lb[0]) * jax.nn.sigmoid(zf)
        fb = lb[1] + (1.0 - lb[1]) * jax.nn.sigmoid(zb)
        fwd = (heads(jnp.log(ff), HG_DK), heads(1.0 - ff, HG_DK))
        bwd = (heads(jnp.log(fb), HG_DK), heads(1.0 - fb, HG_DK))
        return heads(q, HG_DK), heads(i, HG_DV), g, fwd, bwd

    def flip(a):
        return jnp.flip(a, axis=1)

    def readout(o, g, dtype):
        on = rms_norm(o, jnp.ones((HG_DV,), jnp.float32)).reshape(o.shape[:2] + (HG_V,))
        return ((on * norm_g * jax.nn.silu(g)).astype(dtype)) @ w_out

    B = h.shape[0]
    s0 = jnp.zeros((B, HG_HEADS, HG_DK, HG_DV), jnp.float32)
    qc, ic, gc, (lfc, kfc), (lbc, kbc) = prep(hc)
    oc_f, sc_f = gla_chunked(qc, kfc, ic, lfc, s0)
    oc_b, sc_b = gla_chunked(flip(qc), flip(kbc), flip(ic), flip(lbc), s0)
    q, i, g, (lf, kf), (lbk, kb) = prep(h)
    o_f, _ = gla_chunked(q, kf, i, lf, sc_f)
    o_b, _ = gla_chunked(flip(q), flip(kb), flip(i), flip(lbk), sc_b)
    y = readout(o_f + flip(o_b), g, h.dtype)
    if not need_ctx_out:
        return y, None
    return y, readout(oc_f + flip(oc_b), gc, hc.dtype)


def peer_ffn(h, w_q, sub_keys, u, v):
    shp = h.shape
    x = h.reshape(-1, shp[-1])
    n = x.shape[0]
    q = (x @ w_q).reshape(n, PEER_HEADS, 2, PEER_HALF)
    s = jnp.einsum('nhpd,hpkd->nhpk', q, sub_keys).astype(jnp.float32)
    sv, si = lax.top_k(s, PEER_TOPK)
    cand = (sv[:, :, 0, :, None] + sv[:, :, 1, None, :]).reshape(n, PEER_HEADS, PEER_TOPK * PEER_TOPK)
    cidx = (si[:, :, 0, :, None] * PEER_NKEYS + si[:, :, 1, None, :]).reshape(n, PEER_HEADS, PEER_TOPK * PEER_TOPK)
    top_s, pos = lax.top_k(cand, PEER_TOPK)
    eidx = jnp.take_along_axis(cidx, pos, axis=-1)
    gate = jax.nn.softmax(top_s, axis=-1).astype(x.dtype)
    nb = n // PEER_BLOCK

    def block(args):
        xb, eb, gb = args
        act = jax.nn.gelu(jnp.einsum('nd,nhkd->nhk', xb, u[eb]), approximate=False)
        return jnp.einsum('nhk,nhkd->nd', gb * act, v[eb])

    y = lax.map(block, (x.reshape(nb, PEER_BLOCK, shp[-1]),
                        eidx.reshape(nb, PEER_BLOCK, PEER_HEADS, PEER_TOPK),
                        gate.reshape(nb, PEER_BLOCK, PEER_HEADS, PEER_TOPK)))
    return y.reshape(shp)


def setup_inputs(seed: int = 0) -> dict:
    key = jax.random.key(seed)
    ks = iter(jax.random.split(key, 32))

    def nrm(shape, scale):
        return jax.random.normal(next(ks), shape, jnp.float32) * scale

    def gain(shape):
        return 1.0 + nrm(shape, 0.02)

    d = D_MODEL
    return {
        'x': nrm((BATCH, SEQ, d), 1.0),
        'c': nrm((BATCH, d), 1.0),
        'ctx': nrm((BATCH, CTX_LEN, d), 1.0),
        'c_ctx': nrm((d,), 1.0),
        'ada_w': nrm((DEPTH, d, N_MOD * d), 0.5 * d ** -0.5),
        'ada_b': nrm((DEPTH, N_MOD * d), 0.02),
        'norm1_g': gain((DEPTH, d)),
        'norm2_g': gain((DEPTH, d)),
        'ab_w_in': nrm((N_EVEN, d, AB_IN), d ** -0.5),
        'mla_q_norm_g': gain((N_EVEN, MLA_Q_RANK)),
        'mla_w_uq': nrm((N_EVEN, MLA_Q_RANK, MLA_HEADS * (MLA_NOPE + MLA_ROPE)), MLA_Q_RANK ** -0.5),
        'mla_kv_norm_g': gain((N_EVEN, MLA_KV_RANK)),
        'mla_w_ukv': nrm((N_EVEN, MLA_KV_RANK, MLA_HEADS * (MLA_NOPE + MLA_V)), MLA_KV_RANK ** -0.5),
        'conv_w': nrm((N_EVEN, CONV_WIDTH, CONV_CH), CONV_WIDTH ** -0.5),
        'conv_b': nrm((N_EVEN, CONV_CH), 0.02),
        'conv_ln_g': gain((N_EVEN, CONV_CH)),
        'conv_ln_b': nrm((N_EVEN, CONV_CH), 0.02),
        'ab_w_out': nrm((N_EVEN, AB_MIX, d), AB_MIX ** -0.5),
        'hg_w_in': nrm((N_ODD, d, HG_IN), d ** -0.5),
        'hg_lower_bound': nrm((DEPTH, 2, HG_F), 0.1),
        'hg_norm_g': gain((N_ODD, HG_V)),
        'hg_w_out': nrm((N_ODD, HG_V, d), HG_V ** -0.5),
        'peer_w_q': nrm((DEPTH, d, PEER_HEADS * PEER_QDIM), d ** -0.5),
        'peer_sub_keys': nrm((DEPTH, PEER_HEADS, 2, PEER_NKEYS, PEER_HALF), PEER_HALF ** -0.5),
        'peer_u': nrm((DEPTH, PEER_EXPERTS, d), d ** -0.5),
        'peer_v': nrm((DEPTH, PEER_EXPERTS, d), 0.25),
        'final_norm_g': gain((d,)),
    }


def reference(x, c, ctx, c_ctx, ada_w, ada_b, norm1_g, norm2_g, ab_w_in, mla_q_norm_g, mla_w_uq,
              mla_kv_norm_g, mla_w_ukv, conv_w, conv_b, conv_ln_g, conv_ln_b, ab_w_out, hg_w_in,
              hg_lower_bound, hg_norm_g, hg_w_out, peer_w_q, peer_sub_keys, peer_u, peer_v, final_norm_g):
    xc = ctx
    sc = jax.nn.silu(c)
    scc = jax.nn.silu(c_ctx)
    for l in range(DEPTH):
        need_ctx = l < DEPTH - 1
        mod = jnp.split((sc @ ada_w[l] + ada_b[l])[:, None, :], N_MOD, axis=-1)
        modc = jnp.split(scc @ ada_w[l] + ada_b[l], N_MOD, axis=-1)
        h = modulate(rms_norm(x, norm1_g[l]), mod[0], mod[1])
        hc = modulate(rms_norm(xc, norm1_g[l]), modc[0], modc[1])
        if l % 2 == 0:
            e = l // 2
            y, yc = mla_conv_mixer(h, hc, need_ctx, ab_w_in[e], mla_q_norm_g[e], mla_w_uq[e], mla_kv_norm_g[e],
                                   mla_w_ukv[e], conv_w[e], conv_b[e], conv_ln_g[e], conv_ln_b[e], ab_w_out[e])
        else:
            o = l // 2
            y, yc = hgrn_mixer(h, hc, l, need_ctx, hg_w_in[o], hg_lower_bound, hg_norm_g[o], hg_w_out[o])
        x = x + mod[2] * y
        h2 = modulate(rms_norm(x, norm2_g[l]), mod[3], mod[4])
        x = x + mod[5] * peer_ffn(h2, peer_w_q[l], peer_sub_keys[l], peer_u[l], peer_v[l])
        if need_ctx:
            xc = xc + modc[2] * yc
            hc2 = modulate(rms_norm(xc, norm2_g[l]), modc[3], modc[4])
            xc = xc + modc[5] * peer_ffn(hc2, peer_w_q[l], peer_sub_keys[l], peer_u[l], peer_v[l])
    return rms_norm(x, final_norm_g)
```

```cpp
#include <hip/hip_runtime.h>
#include <hip/hip_cooperative_groups.h>
#include <stdint.h>
#include <stdio.h>
namespace cg = cooperative_groups;

#ifndef MEGA
#define MEGA 1
#endif

typedef unsigned short bf16_t;
typedef __attribute__((ext_vector_type(8))) short bf16x8;
typedef __attribute__((ext_vector_type(4))) float f32x4;
typedef __attribute__((ext_vector_type(2))) __bf16 bf2_t;
typedef __attribute__((ext_vector_type(4))) unsigned u32x4;
typedef __attribute__((ext_vector_type(2))) float f32x2;

#define DEV __device__ __forceinline__
#define MM 16384
#define MT 16896
#define MIB ((size_t)1 << 20)

#define OFF_X     ((size_t)0)
#define OFF_H     (66 * MIB)
#define OFF_U1    (103 * MIB)
#define OFF_V1    (131 * MIB)
#define OFF_SMALL (163 * MIB)
#define OFF_U0    (195 * MIB)
#define OFF_V0    (227 * MIB)
#define OFF_R     (259 * MIB)
#define LDH 1088
#define QMIB ((size_t)262144)
#define S_WIN0   (OFF_SMALL)
#define S_WUQ    (OFF_SMALL + 13 * QMIB)
#define S_WUKV   (OFF_SMALL + 13 * QMIB + 393216)
#define S_WOUT0  (OFF_SMALL + 15 * QMIB + 131072)
#define S_WHGIN  (OFF_SMALL + 24 * QMIB)
#define S_WHGOUT (OFF_SMALL + 66 * QMIB + 131072)
#define S_WPQ    (OFF_SMALL + 75 * QMIB)
#define S_SUBK   (OFF_SMALL + 109 * QMIB)
#define S_MOD    (OFF_SMALL + 113 * QMIB)
#define S_ROPEC  (OFF_SMALL + 114 * QMIB)
#define S_ROPES  (OFF_SMALL + 116 * QMIB)
#define S_DECAY  (OFF_SMALL + 118 * QMIB)
#define S_UVSC   (OFF_SMALL + 126 * QMIB + 131072)
#define R_P0   (OFF_R)
#define R_QN   (OFF_R + 50 * MIB)
#define R_KVN  (OFF_R + 59 * MIB)
#define R_YG   (OFF_R + 64 * MIB)
#define R_Q    (OFF_R + 81 * MIB)
#define R_QC   (OFF_R + 105 * MIB)
#define R_K    (OFF_R + 106 * MIB)
#define R_VT   (OFF_R + 131 * MIB)
#define R_MIX  (OFF_R + 148 * MIB)
#define R_EIDX (OFF_R + 184 * MIB)
#define R_GATE (OFF_R + 193 * MIB)
#define R_COEF (OFF_R + 210 * MIB)
#define R_PQ   (OFF_R)
#define L1_QH   (195 * MIB)
#define L1_LF   (228 * MIB)
#define L1_LB   (261 * MIB)
#define L1_IH   (294 * MIB)
#define L1_GH   (327 * MIB)
#define L1_DS   (360 * MIB)
#define L1_PQ   (195 * MIB)
#define L1_EIDX (261 * MIB)
#define L1_GATE (270 * MIB)
#define L1_COEF (287 * MIB)
#define WS_NEED (493 * MIB)

struct Params {
  const float* in[27];
  char* ws;
  float* out;
};
#define WSP(type, off) ((type*)(p.ws + (size_t)(off)))

enum { I_X = 0, I_C, I_CTX, I_CCTX, I_ADAW, I_ADAB, I_N1G, I_N2G, I_WIN, I_QG, I_WUQ, I_KVG, I_WUKV, I_CONVW, I_CONVB,
       I_LNG, I_LNB, I_WOUT, I_HGWIN, I_HGLB, I_HGNG, I_HGWOUT, I_PWQ, I_PSK, I_PU, I_PV, I_FNG };

DEV int tidx() { int t = threadIdx.x; asm volatile("" : "+v"(t)); return t; }
DEV unsigned short f2bf(float x) { return __builtin_bit_cast(unsigned short, (__bf16)x); }
DEV float bf2f(unsigned short b) { return __uint_as_float(((unsigned)b) << 16); }
DEV unsigned pack2(float a, float b) { f32x2 v = {a, b}; return __builtin_bit_cast(unsigned, __builtin_convertvector(v, bf2_t)); }
DEV float bflo(unsigned u) { return __uint_as_float(u << 16); }
DEV float bfhi(unsigned u) { return __uint_as_float(u & 0xffff0000u); }
DEV float wave_sum(float v) {
#pragma unroll
  for (int o = 32; o > 0; o >>= 1) v += __shfl_xor(v, o);
  return v;
}
DEV float sigm(float x) { return 1.f / (1.f + __expf(-x)); }
DEV f32x4 mfma16(bf16x8 a, bf16x8 b, f32x4 c) { return __builtin_amdgcn_mfma_f32_16x16x32_bf16(a, b, c, 0, 0, 0); }
DEV float dot2bf(unsigned a, unsigned b, float c) {
  return __builtin_amdgcn_fdot2_f32_bf16(__builtin_bit_cast(bf2_t, a), __builtin_bit_cast(bf2_t, b), c, false);
}

template <int TI, int TJ, int KS>
DEV void mfma_lds(const bf16_t* Arows, int lda, const bf16_t* Brows, int ldb, int i0, int j0, f32x4 (&acc)[TI][TJ]) {
  const int lane = tidx() & 63, l15 = lane & 15, quad = lane >> 4;
#pragma unroll
  for (int ks = 0; ks < KS; ks++) {
    bf16x8 af[TI], bfr[TJ];
#pragma unroll
    for (int i = 0; i < TI; i++) af[i] = *(const bf16x8*)(Arows + (i0 + i * 16 + l15) * lda + ks * 32 + quad * 8);
#pragma unroll
    for (int j = 0; j < TJ; j++) bfr[j] = *(const bf16x8*)(Brows + (j0 + j * 16 + l15) * ldb + ks * 32 + quad * 8);
#pragma unroll
    for (int i = 0; i < TI; i++)
#pragma unroll
      for (int j = 0; j < TJ; j++) acc[i][j] = mfma16(af[i], bfr[j], acc[i][j]);
  }
}

#define GLD 80
template <class Epi>
DEV void gemm_tile(const bf16_t* __restrict__ A, int lda, const bf16_t* __restrict__ Bt, int ldb, int K, int m0, int n0,
                   Epi& epi, char* smem) {
  bf16_t* As = (bf16_t*)smem;
  bf16_t* Bs = As + 128 * GLD;
  const int tid = tidx(), lane = tid & 63, w = tid >> 6, wm = w >> 1, wn = w & 1;
  const int l15 = lane & 15, quad = lane >> 4;
  f32x4 acc[4][4];
#pragma unroll
  for (int i = 0; i < 4; i++)
#pragma unroll
    for (int j = 0; j < 4; j++) acc[i][j] = (f32x4){0.f, 0.f, 0.f, 0.f};
  u32x4 ra0[4], rb0[4], ra1[4], rb1[4];
  const int nk = K >> 6;
  const int lrow = tid >> 3, lcc = tid & 7;
  const bf16_t* Ap = A + (size_t)(m0 + lrow) * lda + lcc * 8;
  const bf16_t* Bp = Bt + (size_t)(n0 + lrow) * ldb + lcc * 8;
#define G_LOAD(RA, RB, KT) { _Pragma("unroll") for (int i = 0; i < 4; i++) { \
      RA[i] = *(const u32x4*)(Ap + (size_t)(i * 32) * lda + (KT) * 64); RB[i] = *(const u32x4*)(Bp + (size_t)(i * 32) * ldb + (KT) * 64); } }
#define G_STORE(RA, RB) { _Pragma("unroll") for (int i = 0; i < 4; i++) { \
      *(u32x4*)(As + (lrow + i * 32) * GLD + lcc * 8) = RA[i]; *(u32x4*)(Bs + (lrow + i * 32) * GLD + lcc * 8) = RB[i]; } }
  G_LOAD(ra0, rb0, 0);
  G_LOAD(ra1, rb1, 1);
  for (int kt = 0; kt < nk; kt += 2) {
    __syncthreads();
    G_STORE(ra0, rb0);
    __syncthreads();
    if (kt + 2 < nk) G_LOAD(ra0, rb0, kt + 2);
    mfma_lds<4, 4, 2>(Bs, GLD, As, GLD, wn * 64, wm * 64, acc);
    __syncthreads();
    G_STORE(ra1, rb1);
    __syncthreads();
    if (kt + 3 < nk) G_LOAD(ra1, rb1, kt + 3);
    mfma_lds<4, 4, 2>(Bs, GLD, As, GLD, wn * 64, wm * 64, acc);
  }
#undef G_LOAD
#undef G_STORE
#pragma unroll
  for (int i = 0; i < 4; i++)
#pragma unroll
    for (int j = 0; j < 4; j++) epi(m0 + wm * 64 + j * 16 + l15, n0 + wn * 64 + i * 16 + quad * 4, acc[i][j]);
}

DEV void transpose_tile(const float* __restrict__ W, int K, int N, bf16_t* __restrict__ Wt, int ldt, int tile, char* smem) {
  float* sm = (float*)smem;
  const int ntn = N >> 5;
  const int kt = tile / ntn, nt = tile - kt * ntn;
  const int tx = tidx() & 31, ty = tidx() >> 5;
  __syncthreads();
#pragma unroll
  for (int i = 0; i < 4; i++) { int k = ty + i * 8; sm[k * 33 + tx] = W[(size_t)(kt * 32 + k) * N + nt * 32 + tx]; }
  __syncthreads();
#pragma unroll
  for (int i = 0; i < 4; i++) { int n = ty + i * 8; Wt[(size_t)(nt * 32 + n) * ldt + kt * 32 + tx] = f2bf(sm[tx * 33 + n]); }
}
DEV void convert_chunk(const float* __restrict__ src, bf16_t* __restrict__ dst, int chunk) {
  size_t o = (size_t)chunk * 2048 + tidx() * 8;
  float4 a = *(const float4*)(src + o), b = *(const float4*)(src + o + 4);
  uint4 r; r.x = pack2(a.x, a.y); r.y = pack2(a.z, a.w); r.z = pack2(b.x, b.y); r.w = pack2(b.z, b.w);
  *(uint4*)(dst + o) = r;
}

#define NT_WIN   1440
#define NT_WUQ   192
#define NT_WUKV  128
#define NT_WOUT  1024
#define NT_HGIN  5120
#define NT_HGOUT 1024
#define NT_WPQ   4096
#define P0_TR (NT_WIN + NT_WUQ + NT_WUKV + NT_WOUT + NT_HGIN + NT_HGOUT + NT_WPQ)
#define P0_CV_SUBK 256
#define P0_CV_U 2048
#define P0_CV_V 2048
#define P0_ZP 51
#define P0_MOD 384
#define P0_ROPE 512
#define P0_ITEMS (P0_TR + P0_CV_SUBK + P0_CV_U + P0_CV_V + P0_ZP + P0_MOD + P0_ROPE)

DEV void phase_prep(const Params& p, char* smem) {
  for (int item = blockIdx.x; item < P0_ITEMS; item += gridDim.x) {
    int it = item;
    if (it < P0_TR) {
      if (it < NT_WIN) { transpose_tile(p.in[I_WIN], 1024, 1440, WSP(bf16_t, S_WIN0), LDH, it, smem); continue; }
      it -= NT_WIN;
      if (it < NT_WUQ) { transpose_tile(p.in[I_WUQ], 256, 768, WSP(bf16_t, S_WUQ), 256, it, smem); continue; }
      it -= NT_WUQ;
      if (it < NT_WUKV) { transpose_tile(p.in[I_WUKV], 128, 1024, WSP(bf16_t, S_WUKV), 128, it, smem); continue; }
      it -= NT_WUKV;
      if (it < NT_WOUT) { transpose_tile(p.in[I_WOUT], 1024, 1024, WSP(bf16_t, S_WOUT0), LDH, it, smem); continue; }
      it -= NT_WOUT;
      if (it < NT_HGIN) { transpose_tile(p.in[I_HGWIN], 1024, 5120, WSP(bf16_t, S_WHGIN), LDH, it, smem); continue; }
      it -= NT_HGIN;
      if (it < NT_HGOUT) { transpose_tile(p.in[I_HGWOUT], 1024, 1024, WSP(bf16_t, S_WHGOUT), LDH, it, smem); continue; }
      it -= NT_HGOUT;
      int l = it >> 11; it &= 2047;
      transpose_tile(p.in[I_PWQ] + (size_t)l * 1024 * 2048, 1024, 2048, WSP(bf16_t, S_WPQ) + (size_t)l * 2048 * LDH, LDH, it, smem);
      continue;
    }
    it -= P0_TR;
    if (it < P0_CV_SUBK) { convert_chunk(p.in[I_PSK], WSP(bf16_t, S_SUBK), it); continue; }
    it -= P0_CV_SUBK;
    if (it < P0_CV_U + P0_CV_V) {
      const int isv = it >= P0_CV_U; const int r16 = isv ? it - P0_CV_U : it;
      const int lane = tidx() & 63;
      const int rowb = r16 * 16 + (tidx() >> 6) * 4;
      const float* src = (isv ? p.in[I_PV] : p.in[I_PU]) + (size_t)rowb * 1024 + lane * 16;
      float4 v[4][4];
#pragma unroll
      for (int r = 0; r < 4; r++)
#pragma unroll
        for (int q = 0; q < 4; q++) v[r][q] = *(const float4*)(src + (size_t)r * 1024 + q * 4);
#pragma unroll
      for (int r = 0; r < 4; r++) {
        float mx = 0.f;
#pragma unroll
        for (int q = 0; q < 4; q++) mx = fmaxf(mx, fmaxf(fmaxf(fabsf(v[r][q].x), fabsf(v[r][q].y)), fmaxf(fabsf(v[r][q].z), fabsf(v[r][q].w))));
#pragma unroll
        for (int o = 32; o > 0; o >>= 1) mx = fmaxf(mx, __shfl_xor(mx, o));
        mx = fmaxf(mx, 1e-30f);
        const float sc = exp2f(floorf(log2f(384.f / mx)));
        unsigned ow[4];
#pragma unroll
        for (int q = 0; q < 4; q++) {
          int t = __builtin_amdgcn_cvt_pk_fp8_f32(v[r][q].x * sc, v[r][q].y * sc, 0, false);
          t = __builtin_amdgcn_cvt_pk_fp8_f32(v[r][q].z * sc, v[r][q].w * sc, t, true);
          ow[q] = (unsigned)t;
        }
        const int row = rowb + r; const int l = row >> 14, e = row & 16383;
        unsigned char* dst = isv ? (l ? WSP(unsigned char, OFF_V1) : WSP(unsigned char, OFF_V0)) : (l ? WSP(unsigned char, OFF_U1) : WSP(unsigned char, OFF_U0));
        *(uint4*)(dst + (size_t)e * 1024 + lane * 16) = make_uint4(ow[0], ow[1], ow[2], ow[3]);
        if (lane == 0) WSP(float, S_UVSC)[(l * 2 + isv) * 16384 + e] = 1.f / sc;
      }
      continue;
    }
    it -= P0_CV_U;
    it -= P0_CV_V;
    if (it < P0_ZP) {
      bf16_t* dst = WSP(bf16_t, S_WIN0) + (size_t)1440 * LDH + (size_t)it * 2048 + tidx() * 8;
      *(uint4*)dst = make_uint4(0u, 0u, 0u, 0u);
      continue;
    }
    it -= P0_ZP;
    if (it < P0_MOD) {
      const int l = it / 192, nb = it - l * 192;
      const int col = tidx() & 31, kg = tidx() >> 5;
      const int n = nb * 32 + col;
      const float* W = p.in[I_ADAW] + (size_t)l * 1024 * 6144;
      float* sv = (float*)smem;
      float* red = sv + 3072;
      __syncthreads();
      for (int i = tidx(); i < 3072; i += 256) {
        const int r = i >> 10, k = i & 1023;
        const float c = (r < 2) ? p.in[I_C][r * 1024 + k] : p.in[I_CCTX][k];
        sv[i] = c * sigm(c);
      }
      __syncthreads();
      float a0 = 0.f, a1 = 0.f, a2 = 0.f;
      const float* wp = W + (size_t)(kg * 128) * 6144 + n;
#pragma unroll 1
      for (int kb = 0; kb < 128; kb += 32) {
        float wv[32];
#pragma unroll
        for (int u = 0; u < 32; u++) wv[u] = wp[(size_t)(kb + u) * 6144];
#pragma unroll
        for (int u = 0; u < 32; u++) {
          const int k = kg * 128 + kb + u;
          a0 += sv[k] * wv[u]; a1 += sv[1024 + k] * wv[u]; a2 += sv[2048 + k] * wv[u];
        }
      }
      red[(kg * 32 + col) * 3 + 0] = a0; red[(kg * 32 + col) * 3 + 1] = a1; red[(kg * 32 + col) * 3 + 2] = a2;
      __syncthreads();
      if (tidx() < 96) {
        int r = tidx() >> 5, cc = tidx() & 31;
        float sum = 0.f;
        for (int g = 0; g < 8; g++) sum += red[(g * 32 + cc) * 3 + r];
        int nn = nb * 32 + cc;
        WSP(float, S_MOD)[(size_t)(l * 3 + r) * 6144 + nn] = sum + p.in[I_ADAB][l * 6144 + nn];
      }
      continue;
    }
    it -= P0_MOD;
    {
      int idx = it * 256 + tidx();
      int t = idx >> 4, i = idx & 15;
      int f = i & 7;
      float pos = (i < 8) ? (float)(t >> 6) : (float)(t & 63);
      float inv = powf(10000.f, -(float)(2 * f) / 16.f);
      float ang = pos * inv;
      WSP(float, S_ROPEC)[idx] = cosf(ang);
      WSP(float, S_ROPES)[idx] = sinf(ang);
    }
  }
}

DEV void phase_norm(const Params& p, int layer, int which, int M, bool from_inputs) {
  const float* g = p.in[which ? I_N2G : I_N1G] + layer * 1024;
  const float* mod = WSP(float, S_MOD) + (size_t)layer * 3 * 6144;
  const int shift_c = which ? 3 : 0, scale_c = which ? 4 : 1;
  const float* X = WSP(float, OFF_X);
  bf16_t* H = WSP(bf16_t, OFF_H);
  const int wave = tidx() >> 6, lane = tidx() & 63;
  for (int row = blockIdx.x * 4 + wave; row < M; row += gridDim.x * 4) {
    const float* src; int mr;
    if (row < MM) { src = (from_inputs ? p.in[I_X] : X) + (size_t)row * 1024; mr = row >> 13; }
    else { src = from_inputs ? (p.in[I_CTX] + (size_t)(row - MM) * 1024) : (X + (size_t)row * 1024); mr = 2; }
    float4 v[4]; float ss = 0.f;
#pragma unroll
    for (int i = 0; i < 4; i++) {
      v[i] = ((const float4*)src)[lane + i * 64];
      ss += v[i].x * v[i].x + v[i].y * v[i].y + v[i].z * v[i].z + v[i].w * v[i].w;
    }
    ss = wave_sum(ss);
    const float rinv = rsqrtf(ss * (1.f / 1024.f) + 1e-6f);
    const float* msh = mod + (size_t)mr * 6144 + shift_c * 1024;
    const float* msc = mod + (size_t)mr * 6144 + scale_c * 1024;
#pragma unroll
    for (int i = 0; i < 4; i++) {
      int c4 = lane + i * 64;
      float4 g4 = ((const float4*)g)[c4], sh = ((const float4*)msh)[c4], sc = ((const float4*)msc)[c4];
      float o0 = v[i].x * rinv * g4.x * (1.f + sc.x) + sh.x;
      float o1 = v[i].y * rinv * g4.y * (1.f + sc.y) + sh.y;
      float o2 = v[i].z * rinv * g4.z * (1.f + sc.z) + sh.z;
      float o3 = v[i].w * rinv * g4.w * (1.f + sc.w) + sh.w;
      uint2 r; r.x = pack2(o0, o1); r.y = pack2(o2, o3);
      *(uint2*)(H + (size_t)row * LDH + c4 * 4) = r;
    }
  }
}

struct EpiP0 {
  bf16_t* P0;
  DEV void operator()(int m, int n, f32x4 v) {
    if (n < 1440) { uint2 r; r.x = pack2(v[0], v[1]); r.y = pack2(v[2], v[3]); *(uint2*)(P0 + (size_t)m * 1536 + n) = r; }
  }
};
DEV void phase_gemm_win(const Params& p, char* smem) {
  EpiP0 epi{WSP(bf16_t, R_P0)};
  const int NTL = 12, items = (MT / 128) * NTL;
  for (int item = blockIdx.x; item < items; item += gridDim.x) {
    int mt = item / NTL, nt = item - mt * NTL;
    gemm_tile(WSP(bf16_t, OFF_H), LDH, WSP(bf16_t, S_WIN0), LDH, 1024, mt * 128, nt * 128, epi, smem);
  }
}

DEV void phase_post1(const Params& p) {
  const bf16_t* P0 = WSP(bf16_t, R_P0);
  bf16_t* QN = WSP(bf16_t, R_QN); bf16_t* KVN = WSP(bf16_t, R_KVN); bf16_t* YG = WSP(bf16_t, R_YG);
  bf16_t* Kb = WSP(bf16_t, R_K);
  const float* rc = WSP(float, S_ROPEC); const float* rs = WSP(float, S_ROPES);
  const float* qg = p.in[I_QG]; const float* kvg = p.in[I_KVG];
  const int wave = tidx() >> 6, lane = tidx() & 63;
  for (int row = blockIdx.x * 4 + wave; row < MT; row += gridDim.x * 4) {
    const bf16_t* pr = P0 + (size_t)row * 1536;
    {
      uint2 u = *(const uint2*)(pr + lane * 4);
      float a0 = bflo(u.x), a1 = bfhi(u.x), a2 = bflo(u.y), a3 = bfhi(u.y);
      float ss = wave_sum(a0 * a0 + a1 * a1 + a2 * a2 + a3 * a3);
      float rinv = rsqrtf(ss * (1.f / 256.f) + 1e-6f);
      float4 g4 = ((const float4*)qg)[lane];
      uint2 r; r.x = pack2(a0 * rinv * g4.x, a1 * rinv * g4.y); r.y = pack2(a2 * rinv * g4.z, a3 * rinv * g4.w);
      *(uint2*)(QN + (size_t)row * 256 + lane * 4) = r;
    }
    {
      unsigned u = *(const unsigned*)(pr + 256 + lane * 2);
      float a0 = bflo(u), a1 = bfhi(u);
      float ss = wave_sum(a0 * a0 + a1 * a1);
      float rinv = rsqrtf(ss * (1.f / 128.f) + 1e-6f);
      float2 g2 = ((const float2*)kvg)[lane];
      *(unsigned*)(KVN + (size_t)row * 128 + lane * 2) = pack2(a0 * rinv * g2.x, a1 * rinv * g2.y);
    }
    if (lane < 16) {
      unsigned u = *(const unsigned*)(pr + 384 + lane * 2);
      float x0 = bflo(u), x1 = bfhi(u);
      int b, pos;
      if (row < MM) {
        b = row >> 13; int t = row & 8191; pos = 256 + t;
        float c = rc[t * 16 + lane], s = rs[t * 16 + lane];
        float y0 = x0 * c - x1 * s, y1 = x0 * s + x1 * c; x0 = y0; x1 = y1;
      } else { int rr = row - MM; b = rr >> 8; pos = rr & 255; }
      unsigned o = pack2(x0, x1);
#pragma unroll
      for (int h = 0; h < 8; h++) *(unsigned*)(Kb + ((size_t)(b * 8 + h) * 8448 + pos) * 96 + 64 + lane * 2) = o;
    }
    {
      uint4 ua = *(const uint4*)(pr + 416 + lane * 8);
      uint4 ug = *(const uint4*)(pr + 416 + 512 + lane * 8);
      uint4 r;
      r.x = pack2(bflo(ua.x) * sigm(bflo(ug.x)), bfhi(ua.x) * sigm(bfhi(ug.x)));
      r.y = pack2(bflo(ua.y) * sigm(bflo(ug.y)), bfhi(ua.y) * sigm(bfhi(ug.y)));
      r.z = pack2(bflo(ua.z) * sigm(bflo(ug.z)), bfhi(ua.z) * sigm(bfhi(ug.z)));
      r.w = pack2(bflo(ua.w) * sigm(bflo(ug.w)), bfhi(ua.w) * sigm(bfhi(ug.w)));
      *(uint4*)(YG + (size_t)row * 512 + lane * 8) = r;
    }
  }
}

#define QSCALE 0.14724738f
struct EpiQ {
  bf16_t* Q; bf16_t* Qc; const float* rc; const float* rs;
  DEV void operator()(int m, int n, f32x4 v) {
    int head = n / 96, d = n - head * 96;
    if (m < MM) {
      int b = m >> 13, t = m & 8191;
      if (d >= 64) {
        int i0 = (d - 64) >> 1;
        float c0 = rc[t * 16 + i0], s0 = rs[t * 16 + i0], c1 = rc[t * 16 + i0 + 1], s1 = rs[t * 16 + i0 + 1];
        float y0 = v[0] * c0 - v[1] * s0, y1 = v[0] * s0 + v[1] * c0;
        float y2 = v[2] * c1 - v[3] * s1, y3 = v[2] * s1 + v[3] * c1;
        v[0] = y0; v[1] = y1; v[2] = y2; v[3] = y3;
      }
      uint2 r; r.x = pack2(v[0] * QSCALE, v[1] * QSCALE); r.y = pack2(v[2] * QSCALE, v[3] * QSCALE);
      *(uint2*)(Q + ((size_t)(b * 8 + head) * 8192 + t) * 96 + d) = r;
    } else {
      int rr = m - MM; int b = rr >> 8, t = rr & 255;
      uint2 r; r.x = pack2(v[0] * QSCALE, v[1] * QSCALE); r.y = pack2(v[2] * QSCALE, v[3] * QSCALE);
      *(uint2*)(Qc + ((size_t)(b * 8 + head) * 256 + t) * 96 + d) = r;
    }
  }
};
struct EpiKV {
  bf16_t* K; bf16_t* Vt;
  DEV void operator()(int m, int n, f32x4 v) {
    int head = n >> 7, d = n & 127;
    int b, pos;
    if (m < MM) { b = m >> 13; pos = 256 + (m & 8191); } else { int rr = m - MM; b = rr >> 8; pos = rr & 255; }
    if (d < 64) {
      uint2 r; r.x = pack2(v[0], v[1]); r.y = pack2(v[2], v[3]);
      *(uint2*)(K + ((size_t)(b * 8 + head) * 8448 + pos) * 96 + d) = r;
    } else {
      bf16_t* vp = Vt + ((size_t)(b * 8 + head) * 64 + (d - 64)) * 8448 + pos;
      vp[0] = f2bf(v[0]); vp[8448] = f2bf(v[1]); vp[2 * 8448] = f2bf(v[2]); vp[3 * 8448] = f2bf(v[3]);
    }
  }
};

DEV void conv_tile(const Params& p, int tile, char* smem) {
  const bf16_t* YG = WSP(bf16_t, R_YG);
  bf16_t* MIX = WSP(bf16_t, R_MIX);
  const int r0 = tile * 8;
  int seq_start, seq_len;
  if (r0 < MM) { seq_start = (r0 >> 13) << 13; seq_len = 8192; }
  else { int rr = r0 - MM; seq_start = MM + ((rr >> 8) << 8); seq_len = 256; }
  const int t0 = r0 - seq_start;
  const int tid = tidx();
  const int c = tid * 2;
  const int lane = tid & 63, w = tid >> 6;
  bf16_t* stg = (bf16_t*)smem;
  float* ybuf = (float*)(smem + 38 * 1024);
  float* red = ybuf + 8 * 512;
  __syncthreads();
  for (int id = tid; id < 38 * 64; id += 256) {
    const int row = id >> 6, cc = id & 63;
    const int t = t0 - 15 + row;
    uint4 v = make_uint4(0u, 0u, 0u, 0u);
    if (t >= 0 && t < seq_len) v = *(const uint4*)(YG + (size_t)(seq_start + t) * 512 + cc * 8);
    *(uint4*)(stg + row * 512 + cc * 8) = v;
  }
  float w0[31], w1[31];
  const float* cw = p.in[I_CONVW];
#pragma unroll
  for (int i = 0; i < 31; i++) { float2 t = *(const float2*)(cw + i * 512 + c); w0[i] = t.x; w1[i] = t.y; }
  const float2 bb = *(const float2*)(p.in[I_CONVB] + c);
  __syncthreads();
#pragma unroll 1
  for (int i = 0; i < 8; i++) {
    float a0 = bb.x, a1 = bb.y;
#pragma unroll
    for (int wi = 0; wi < 31; wi++) {
      unsigned u = *(const unsigned*)(stg + (i + wi) * 512 + c);
      a0 += bflo(u) * w0[wi]; a1 += bfhi(u) * w1[wi];
    }
    *(float2*)(ybuf + i * 512 + c) = make_float2(a0, a1);
    float s1 = wave_sum(a0 + a1);
    float s2 = wave_sum(a0 * a0 + a1 * a1);
    if (lane == 0) { red[(i * 4 + w) * 2] = s1; red[(i * 4 + w) * 2 + 1] = s2; }
  }
  __syncthreads();
  const float2 lg = *(const float2*)(p.in[I_LNG] + c), lb = *(const float2*)(p.in[I_LNB] + c);
#pragma unroll
  for (int i = 0; i < 8; i++) {
    float S1 = red[i * 8] + red[i * 8 + 2] + red[i * 8 + 4] + red[i * 8 + 6];
    float S2 = red[i * 8 + 1] + red[i * 8 + 3] + red[i * 8 + 5] + red[i * 8 + 7];
    float mean = S1 * (1.f / 512.f);
    float var = fmaxf(S2 * (1.f / 512.f) - mean * mean, 0.f);
    float rinv = rsqrtf(var + 1e-6f);
    float2 y = *(const float2*)(ybuf + i * 512 + c);
    float y0 = (y.x - mean) * rinv * lg.x + lb.x;
    float y1 = (y.y - mean) * rinv * lg.y + lb.y;
    y0 = y0 * sigm(y0); y1 = y1 * sigm(y1);
    *(unsigned*)(MIX + (size_t)(r0 + i) * LDH + 512 + c) = pack2(y0, y1);
  }
}

#define NI_GQ (132 * 6)
#define NI_GKV (132 * 8)
#define NI_CONV (MT / 8)
DEV void phase_qkv_conv(const Params& p, char* smem) {
  EpiQ eq{WSP(bf16_t, R_Q), WSP(bf16_t, R_QC), WSP(float, S_ROPEC), WSP(float, S_ROPES)};
  EpiKV ekv{WSP(bf16_t, R_K), WSP(bf16_t, R_VT)};
  for (int item = blockIdx.x; item < NI_GQ + NI_GKV + NI_CONV; item += gridDim.x) {
    int it = item;
    if (it < NI_GQ) { int mt = it / 6, nt = it - mt * 6; gemm_tile(WSP(bf16_t, R_QN), 256, WSP(bf16_t, S_WUQ), 256, 256, mt * 128, nt * 128, eq, smem); continue; }
    it -= NI_GQ;
    if (it < NI_GKV) { int mt = it >> 3, nt = it & 7; gemm_tile(WSP(bf16_t, R_KVN), 128, WSP(bf16_t, S_WUKV), 128, 128, mt * 128, nt * 128, ekv, smem); continue; }
    it -= NI_GKV;
    conv_tile(p, it, smem);
  }
}

typedef __attribute__((ext_vector_type(16))) float f32x16;
DEV f32x16 mfma32(bf16x8 a, bf16x8 b, f32x16 c) { return __builtin_amdgcn_mfma_f32_32x32x16_bf16(a, b, c, 0, 0, 0); }
#define ASTR 104
#define VSTR 44
DEV void attn_item(const Params& p, int item, char* smem) {
  const int tid = tidx(), lane = tid & 63, w = tid >> 6, c31 = lane & 31, hf = lane >> 5;
  const bf16_t* Qb; int nkeys; size_t out_row0; int bh;
  if (item < 512) {
    bh = item >> 5; int q0 = (item & 31) * 256;
    Qb = WSP(bf16_t, R_Q) + ((size_t)bh * 8192 + q0) * 96; nkeys = 8448; out_row0 = (size_t)(bh >> 3) * 8192 + q0;
  } else {
    bh = item - 512;
    Qb = WSP(bf16_t, R_QC) + ((size_t)bh * 256) * 96; nkeys = 256; out_row0 = (size_t)MM + (bh >> 3) * 256;
  }
  const int h = bh & 7;
  const bf16_t* Kb = WSP(bf16_t, R_K) + (size_t)bh * 8448 * 96;
  const bf16_t* Vb = WSP(bf16_t, R_VT) + (size_t)bh * 64 * 8448;
  bf16_t* Ks = (bf16_t*)smem;
  bf16_t* Vs = Ks + 2 * 32 * ASTR;
  bf16x8 qf[2][6];
#pragma unroll
  for (int jt = 0; jt < 2; jt++)
#pragma unroll
    for (int ks = 0; ks < 6; ks++) qf[jt][ks] = *(const bf16x8*)(Qb + (size_t)(w * 64 + jt * 32 + c31) * 96 + ks * 16 + hf * 8);
  f32x16 o[2][2];
#pragma unroll
  for (int dt = 0; dt < 2; dt++)
#pragma unroll
    for (int jt = 0; jt < 2; jt++)
#pragma unroll
      for (int r = 0; r < 16; r++) o[dt][jt][r] = 0.f;
  float mrun[2] = {-1e30f, -1e30f}, lrun[2] = {0.f, 0.f};
  u32x4 rk0, rk1, rv0;
  const int k0row = tid / 12, k0cc = tid - k0row * 12;
  const int k1id = 256 + (tid & 127), k1row = k1id / 12, k1cc = k1id - k1row * 12;
  const bool has_k1 = tid < 128;
  const int vrow = tid >> 2, vcc = tid & 3;
  const int ntile = nkeys >> 5;
  __syncthreads();
  rk0 = *(const u32x4*)(Kb + (size_t)k0row * 96 + k0cc * 8);
  rk1 = *(const u32x4*)(Kb + (size_t)k1row * 96 + k1cc * 8);
  rv0 = *(const u32x4*)(Vb + (size_t)vrow * 8448 + vcc * 8);
  *(u32x4*)(Ks + k0row * ASTR + k0cc * 8) = rk0;
  if (has_k1) *(u32x4*)(Ks + k1row * ASTR + k1cc * 8) = rk1;
  *(uint2*)(Vs + vrow * VSTR + vcc * 8) = make_uint2(rv0[0], rv0[1]);
  *(uint2*)(Vs + vrow * VSTR + vcc * 8 + 4) = make_uint2(rv0[2], rv0[3]);
  __syncthreads();
  if (ntile > 1) {
    rk0 = *(const u32x4*)(Kb + (size_t)(32 + k0row) * 96 + k0cc * 8);
    rk1 = *(const u32x4*)(Kb + (size_t)(32 + k1row) * 96 + k1cc * 8);
    rv0 = *(const u32x4*)(Vb + (size_t)vrow * 8448 + 32 + vcc * 8);
  }
  for (int kt = 0; kt < ntile; kt++) {
    const bf16_t* Kc = Ks + (kt & 1) * (32 * ASTR);
    const bf16_t* Vc = Vs + (kt & 1) * (64 * VSTR);
    f32x16 s[2];
#pragma unroll
    for (int jt = 0; jt < 2; jt++) {
#pragma unroll
      for (int r = 0; r < 16; r++) s[jt][r] = 0.f;
#pragma unroll
      for (int ks = 0; ks < 6; ks++) {
        bf16x8 kf = *(const bf16x8*)(Kc + c31 * ASTR + ks * 16 + hf * 8);
        s[jt] = mfma32(kf, qf[jt][ks], s[jt]);
      }
    }
#pragma unroll
    for (int jt = 0; jt < 2; jt++) {
      float m0 = fmaxf(fmaxf(s[jt][0], s[jt][1]), fmaxf(s[jt][2], s[jt][3]));
      float m1 = fmaxf(fmaxf(s[jt][4], s[jt][5]), fmaxf(s[jt][6], s[jt][7]));
      float m2 = fmaxf(fmaxf(s[jt][8], s[jt][9]), fmaxf(s[jt][10], s[jt][11]));
      float m3 = fmaxf(fmaxf(s[jt][12], s[jt][13]), fmaxf(s[jt][14], s[jt][15]));
      const float mx = fmaxf(fmaxf(m0, m1), fmaxf(m2, m3));
      if (__any(mx > mrun[jt])) {
        const float mxa = fmaxf(mx, __shfl_xor(mx, 32));
        const float mnew = fmaxf(mrun[jt], mxa);
        const float alpha = __builtin_amdgcn_exp2f(mrun[jt] - mnew);
        mrun[jt] = mnew;
        lrun[jt] *= alpha;
#pragma unroll
        for (int dt = 0; dt < 2; dt++)
#pragma unroll
          for (int r = 0; r < 16; r++) o[dt][jt][r] *= alpha;
      }
      const float mcur = mrun[jt];
      float pv[16];
#pragma unroll
      for (int r = 0; r < 16; r++) pv[r] = __builtin_amdgcn_exp2f(s[jt][r] - mcur);
      lrun[jt] += (((pv[0] + pv[1]) + (pv[2] + pv[3])) + ((pv[4] + pv[5]) + (pv[6] + pv[7]))) +
                  (((pv[8] + pv[9]) + (pv[10] + pv[11])) + ((pv[12] + pv[13]) + (pv[14] + pv[15])));
      bf16x8 pf[2];
#pragma unroll
      for (int ss = 0; ss < 2; ss++) {
        uint4 u; u.x = pack2(pv[8 * ss + 0], pv[8 * ss + 1]); u.y = pack2(pv[8 * ss + 2], pv[8 * ss + 3]);
        u.z = pack2(pv[8 * ss + 4], pv[8 * ss + 5]); u.w = pack2(pv[8 * ss + 6], pv[8 * ss + 7]);
        pf[ss] = __builtin_bit_cast(bf16x8, u);
      }
#pragma unroll
      for (int dt = 0; dt < 2; dt++)
#pragma unroll
        for (int ss = 0; ss < 2; ss++) {
          uint2 lo = *(const uint2*)(Vc + (dt * 32 + c31) * VSTR + 16 * ss + 4 * hf);
          uint2 hi = *(const uint2*)(Vc + (dt * 32 + c31) * VSTR + 16 * ss + 8 + 4 * hf);
          uint4 u; u.x = lo.x; u.y = lo.y; u.z = hi.x; u.w = hi.y;
          o[dt][jt] = mfma32(__builtin_bit_cast(bf16x8, u), pf[ss], o[dt][jt]);
        }
    }
    if (kt + 1 < ntile) {
      bf16_t* Kn = Ks + ((kt + 1) & 1) * (32 * ASTR);
      bf16_t* Vn = Vs + ((kt + 1) & 1) * (64 * VSTR);
      *(u32x4*)(Kn + k0row * ASTR + k0cc * 8) = rk0;
      if (has_k1) *(u32x4*)(Kn + k1row * ASTR + k1cc * 8) = rk1;
      *(uint2*)(Vn + vrow * VSTR + vcc * 8) = make_uint2(rv0[0], rv0[1]);
      *(uint2*)(Vn + vrow * VSTR + vcc * 8 + 4) = make_uint2(rv0[2], rv0[3]);
      __syncthreads();
      if (kt + 2 < ntile) {
        rk0 = *(const u32x4*)(Kb + (size_t)((kt + 2) * 32 + k0row) * 96 + k0cc * 8);
        rk1 = *(const u32x4*)(Kb + (size_t)((kt + 2) * 32 + k1row) * 96 + k1cc * 8);
        rv0 = *(const u32x4*)(Vb + (size_t)vrow * 8448 + (kt + 2) * 32 + vcc * 8);
      }
    }
  }
  bf16_t* MIX = WSP(bf16_t, R_MIX);
#pragma unroll
  for (int jt = 0; jt < 2; jt++) {
    float l = lrun[jt];
    l += __shfl_xor(l, 32);
    const float inv = 1.f / l;
    const size_t row = out_row0 + w * 64 + jt * 32 + c31;
#pragma unroll
    for (int dt = 0; dt < 2; dt++)
#pragma unroll
      for (int g4 = 0; g4 < 4; g4++) {
        uint2 r; r.x = pack2(o[dt][jt][4 * g4 + 0] * inv, o[dt][jt][4 * g4 + 1] * inv); r.y = pack2(o[dt][jt][4 * g4 + 2] * inv, o[dt][jt][4 * g4 + 3] * inv);
        *(uint2*)(MIX + row * LDH + h * 64 + dt * 32 + 8 * g4 + 4 * hf) = r;
      }
  }
}
DEV void phase_attn(const Params& p, char* smem) {
  for (int item = blockIdx.x; item < 512 + 16; item += gridDim.x) attn_item(p, item, smem);
}

struct EpiRes {
  const float* xin_main; const float* xin_ctx; float* X; const float* mod;
  DEV void operator()(int m, int n, f32x4 v) {
    const float* src; int mr;
    if (m < MM) { src = xin_main + (size_t)m * 1024 + n; mr = m >> 13; } else { src = xin_ctx + (size_t)(m - MM) * 1024 + n; mr = 2; }
    float4 xo = *(const float4*)src;
    float4 g = *(const float4*)(mod + (size_t)mr * 6144 + 2048 + n);
    float4 r; r.x = xo.x + g.x * v[0]; r.y = xo.y + g.y * v[1]; r.z = xo.z + g.z * v[2]; r.w = xo.w + g.w * v[3];
    *(float4*)(X + (size_t)m * 1024 + n) = r;
  }
};
DEV void phase_gemm_out(const Params& p, int layer, char* smem) {
  float* X = WSP(float, OFF_X);
  EpiRes epi;
  epi.X = X; epi.mod = WSP(float, S_MOD) + (size_t)layer * 3 * 6144;
  const bf16_t* A; const bf16_t* Bt; int M;
  if (layer == 0) { epi.xin_main = p.in[I_X]; epi.xin_ctx = p.in[I_CTX]; A = WSP(bf16_t, R_MIX); Bt = WSP(bf16_t, S_WOUT0); M = MT; }
  else { epi.xin_main = X; epi.xin_ctx = X + (size_t)MM * 1024; A = WSP(bf16_t, OFF_H); Bt = WSP(bf16_t, S_WHGOUT); M = MM; }
  const int items = (M / 128) * 8;
  for (int item = blockIdx.x; item < items; item += gridDim.x) {
    int mt = item >> 3, nt = item & 7;
    gemm_tile(A, LDH, Bt, LDH, 1024, mt * 128, nt * 128, epi, smem);
  }
}

struct EpiBf {
  bf16_t* C; int ldc;
  DEV void operator()(int m, int n, f32x4 v) {
    uint2 r; r.x = pack2(v[0], v[1]); r.y = pack2(v[2], v[3]);
    *(uint2*)(C + (size_t)m * ldc + n) = r;
  }
};
DEV void phase_gemm_pq(const Params& p, int layer, int M, char* smem) {
  EpiBf epi{layer ? WSP(bf16_t, L1_PQ) : WSP(bf16_t, R_PQ), 2048};
  const bf16_t* Bt = WSP(bf16_t, S_WPQ) + (size_t)layer * 2048 * LDH;
  const int items = (M / 128) * 16;
  for (int item = blockIdx.x; item < items; item += gridDim.x) {
    int mt = item >> 4, nt = item & 15;
    gemm_tile(WSP(bf16_t, OFF_H), LDH, Bt, LDH, 1024, mt * 128, nt * 128, epi, smem);
  }
}

DEV void ce(float& a, float& b) { float hi = fmaxf(a, b), lo = fminf(a, b); a = hi; b = lo; }
DEV void bitonic16(float (&l)[16]) {
#pragma unroll
  for (int s = 8; s > 0; s >>= 1)
#pragma unroll
    for (int i = 0; i < 16; i++)
      if (!(i & s)) ce(l[i], l[i + s]);
}
DEV void sort16_desc(float (&a)[16]) {
#pragma unroll
  for (int k = 2; k <= 16; k <<= 1)
#pragma unroll
    for (int j = k >> 1; j > 0; j >>= 1)
#pragma unroll
      for (int i = 0; i < 16; i++) {
        const int p = i ^ j;
        if (p > i) { if ((i & k) == 0) ce(a[i], a[p]); else ce(a[p], a[i]); }
      }
}
DEV void merge_xor(float (&l)[16], int mask) {
  float t[16];
#pragma unroll
  for (int i = 0; i < 16; i++) t[i] = __shfl_xor(l[15 - i], mask);
#pragma unroll
  for (int i = 0; i < 16; i++) l[i] = fmaxf(l[i], t[i]);
  bitonic16(l);
}
DEV void peer_top16(const bf16_t* __restrict__ pq, const bf16_t* sk  , float (&l)[16]) {
  const int lane = tidx() & 63, l15 = lane & 15, quad = lane >> 4;
  f32x4 acc[8];
#pragma unroll
  for (int nt = 0; nt < 8; nt++) acc[nt] = (f32x4){0.f, 0.f, 0.f, 0.f};
#pragma unroll 1
  for (int ks = 0; ks < 4; ks++) {
    const bf16x8 bqk = *(const bf16x8*)(pq + ks * 32 + quad * 8);
#pragma unroll
    for (int nt = 0; nt < 8; nt++) {
      bf16x8 ak = *(const bf16x8*)(sk + (nt * 16 + l15) * 144 + ks * 32 + quad * 8);
      acc[nt] = mfma16(ak, bqk, acc[nt]);
    }
  }
  float hi[16];
#pragma unroll
  for (int nt = 0; nt < 4; nt++)
#pragma unroll
    for (int r = 0; r < 4; r++) {
      l[nt * 4 + r] = __uint_as_float((__float_as_uint(acc[nt][r]) & ~127u) | (unsigned)(nt * 16 + quad * 4 + r));
      hi[nt * 4 + r] = __uint_as_float((__float_as_uint(acc[nt + 4][r]) & ~127u) | (unsigned)((nt + 4) * 16 + quad * 4 + r));
    }
  sort16_desc(l);
  sort16_desc(hi);
#pragma unroll
  for (int i = 0; i < 16; i++) l[i] = fmaxf(l[i], hi[15 - i]);
  bitonic16(l);
  merge_xor(l, 16);
  merge_xor(l, 32);
}
DEV void phase_peer_score(const Params& p, int layer, int M, char* smem) {
  const bf16_t* PQ = layer ? WSP(bf16_t, L1_PQ) : WSP(bf16_t, R_PQ);
  int* EIDX = layer ? WSP(int, L1_EIDX) : WSP(int, R_EIDX);
  float* GATE = layer ? WSP(float, L1_GATE) : WSP(float, R_GATE);
  const bf16_t* SK = WSP(bf16_t, S_SUBK) + (size_t)layer * 16 * 128 * 128;
  const float* USC = WSP(float, S_UVSC) + (size_t)(layer * 2) * 16384;
  const int tid = tidx(), lane = tid & 63, w = tid >> 6, l15 = lane & 15, quad = lane >> 4;
  const int items = (M / 64) * 8;
  bf16_t* SKs = (bf16_t*)smem;
  int hcur = -1;
  for (int item = blockIdx.x; item < items; item += gridDim.x) {
    const int mtile = item >> 3, h = item & 7;
    if (h != hcur) {
      hcur = h;
      __syncthreads();
#pragma unroll
      for (int i = 0; i < 16; i++) {
        int id = tid + i * 256; int row = id >> 4, cc = id & 15;
        *(uint4*)(SKs + row * 144 + cc * 8) = *(const uint4*)(SK + ((size_t)h * 256 + row) * 128 + cc * 8);
      }
      __syncthreads();
    }
    const int m = mtile * 64 + w * 16 + l15;
    float L0[16], L1[16];
    peer_top16(PQ + (size_t)m * 2048 + h * 256, SKs, L0);
    peer_top16(PQ + (size_t)m * 2048 + h * 256 + 128, SKs + 128 * 144, L1);
    float R[16];
#pragma unroll
    for (int i = 0; i < 16; i++) R[i] = -3.0e38f;
#pragma unroll
    for (int i = 0; i < 16; i++)
#pragma unroll
      for (int j = 0; j < 16; j++)
        if ((i + 1) * (j + 1) <= 16) {
          float v = L0[i] + L1[j];
          v = __uint_as_float((__float_as_uint(v) & ~255u) | (unsigned)(i * 16 + j));
#pragma unroll
          for (int t = 0; t < 16; t++)
            if (t >= (i + 1) * (j + 1) - 1) ce(R[t], v);
        }
    unsigned char* tab = (unsigned char*)smem + 73728 + (w * 16 + l15) * 32;
#pragma unroll
    for (int i = 0; i < 16; i++) { tab[i] = (unsigned char)(__float_as_uint(L0[i]) & 127u); tab[16 + i] = (unsigned char)(__float_as_uint(L1[i]) & 127u); }
    float ev[16]; float sum = 0.f;
#pragma unroll
    for (int t = 0; t < 16; t++) { ev[t] = __expf(R[t] - R[0]); sum += ev[t]; }
    const float inv = 1.f / sum;
    int eid[16];
#pragma unroll
    for (int t = 0; t < 16; t++) {
      unsigned code = __float_as_uint(R[t]) & 255u;
      eid[t] = (int)tab[code >> 4] * 128 + (int)tab[16 + (code & 15u)];
    }
    if (quad == 0) {
      int* eo = EIDX + (size_t)m * 128 + h * 16;
      float* go = GATE + (size_t)m * 128 + h * 16;
      float* uo = go + (size_t)MT * 128;
      float us[16], vs[16];
#pragma unroll
      for (int t = 0; t < 16; t++) { us[t] = USC[eid[t]]; vs[t] = USC[16384 + eid[t]]; }
#pragma unroll
      for (int t = 0; t < 16; t += 4) {
        *(int4*)(eo + t) = make_int4(eid[t], eid[t + 1], eid[t + 2], eid[t + 3]);
        *(float4*)(go + t) = make_float4(ev[t] * inv * vs[t], ev[t + 1] * inv * vs[t + 1], ev[t + 2] * inv * vs[t + 2], ev[t + 3] * inv * vs[t + 3]);
        *(float4*)(uo + t) = make_float4(us[t], us[t + 1], us[t + 2], us[t + 3]);
      }
    }
  }
}

DEV f32x2 fp8dot4(unsigned u, f32x2 xa, f32x2 xb, f32x2 d) {
  d += __builtin_amdgcn_cvt_pk_f32_fp8((int)u, false) * xa;
  d += __builtin_amdgcn_cvt_pk_f32_fp8((int)u, true) * xb;
  return d;
}
DEV void phase_peer_expert(const Params& p, int layer, int M, bool final_, int part, char* smem) {
  const bf16_t* H = WSP(bf16_t, OFF_H);
  const int* EIDX = layer ? WSP(int, L1_EIDX) : WSP(int, R_EIDX);
  const float* GATE = layer ? WSP(float, L1_GATE) : WSP(float, R_GATE);
  const float* USEL = GATE + (size_t)MT * 128;
  const unsigned char* U = layer ? WSP(unsigned char, OFF_U1) : WSP(unsigned char, OFF_U0);
  const unsigned char* V = layer ? WSP(unsigned char, OFF_V1) : WSP(unsigned char, OFF_V0);
  float* X = WSP(float, OFF_X);
  float* COEF = layer ? WSP(float, L1_COEF) : WSP(float, R_COEF);
  const float* mod = WSP(float, S_MOD) + (size_t)layer * 3 * 6144;
  const int tid = tidx(), lane = tid & 63, w = tid >> 6, g = lane >> 4, l16 = lane & 15;
  int* se = (int*)smem + w * 512;
  float* sg = (float*)(se + 128);
  float* su = sg + 128;
  float* coefs = su + 128;
  if (part == 0) {
  for (int m = blockIdx.x * 4 + w; m < M; m += gridDim.x * 4) {
    {
      int2 e2 = *(const int2*)(EIDX + (size_t)m * 128 + lane * 2);
      float2 g2 = *(const float2*)(GATE + (size_t)m * 128 + lane * 2);
      float2 u2 = *(const float2*)(USEL + (size_t)m * 128 + lane * 2);
      *(int2*)(se + lane * 2) = e2; *(float2*)(sg + lane * 2) = g2; *(float2*)(su + lane * 2) = u2;
    }
    const bf16_t* hrow = H + (size_t)m * LDH + l16 * 16;
    f32x2 xf[32];
#pragma unroll
    for (int c = 0; c < 4; c++) {
      uint4 a = *(const uint4*)(hrow + c * 256), bq = *(const uint4*)(hrow + c * 256 + 8);
      xf[c * 8 + 0] = (f32x2){bflo(a.x), bfhi(a.x)}; xf[c * 8 + 1] = (f32x2){bflo(a.y), bfhi(a.y)};
      xf[c * 8 + 2] = (f32x2){bflo(a.z), bfhi(a.z)}; xf[c * 8 + 3] = (f32x2){bflo(a.w), bfhi(a.w)};
      xf[c * 8 + 4] = (f32x2){bflo(bq.x), bfhi(bq.x)}; xf[c * 8 + 5] = (f32x2){bflo(bq.y), bfhi(bq.y)};
      xf[c * 8 + 6] = (f32x2){bflo(bq.z), bfhi(bq.z)}; xf[c * 8 + 7] = (f32x2){bflo(bq.w), bfhi(bq.w)};
    }
    __syncthreads();
    u32x4 cur[8], nxt[8];
    {
      const unsigned char* r0p = U + (size_t)se[g] * 1024 + l16 * 16;
      const unsigned char* r1p = U + (size_t)se[4 + g] * 1024 + l16 * 16;
#pragma unroll
      for (int c = 0; c < 4; c++) { cur[c] = *(const u32x4*)(r0p + c * 256); cur[4 + c] = *(const u32x4*)(r1p + c * 256); }
    }
#pragma unroll 2
    for (int st = 0; st < 16; st++) {
      if (st + 1 < 16) {
        const unsigned char* r0p = U + (size_t)se[(st + 1) * 8 + g] * 1024 + l16 * 16;
        const unsigned char* r1p = U + (size_t)se[(st + 1) * 8 + 4 + g] * 1024 + l16 * 16;
#pragma unroll
        for (int c = 0; c < 4; c++) { nxt[c] = *(const u32x4*)(r0p + c * 256); nxt[4 + c] = *(const u32x4*)(r1p + c * 256); }
      }
      f32x2 da = (f32x2){0.f, 0.f}, db = (f32x2){0.f, 0.f};
#pragma unroll
      for (int c = 0; c < 4; c++) {
        da = fp8dot4(cur[c][0], xf[c * 8 + 0], xf[c * 8 + 1], da); da = fp8dot4(cur[c][1], xf[c * 8 + 2], xf[c * 8 + 3], da);
        da = fp8dot4(cur[c][2], xf[c * 8 + 4], xf[c * 8 + 5], da); da = fp8dot4(cur[c][3], xf[c * 8 + 6], xf[c * 8 + 7], da);
        db = fp8dot4(cur[4 + c][0], xf[c * 8 + 0], xf[c * 8 + 1], db); db = fp8dot4(cur[4 + c][1], xf[c * 8 + 2], xf[c * 8 + 3], db);
        db = fp8dot4(cur[4 + c][2], xf[c * 8 + 4], xf[c * 8 + 5], db); db = fp8dot4(cur[4 + c][3], xf[c * 8 + 6], xf[c * 8 + 7], db);
      }
      float d0 = da.x + da.y, d1 = db.x + db.y;
      d0 += __shfl_xor(d0, 1); d1 += __shfl_xor(d1, 1);
      d0 += __shfl_xor(d0, 2); d1 += __shfl_xor(d1, 2);
      d0 += __shfl_xor(d0, 4); d1 += __shfl_xor(d1, 4);
      d0 += __shfl_xor(d0, 8); d1 += __shfl_xor(d1, 8);
      const int s0 = st * 8 + g, s1 = s0 + 4;
      d0 *= su[s0]; d1 *= su[s1];
      const float a0 = 0.5f * d0 * (1.f + erff(d0 * 0.70710678118f));
      const float a1 = 0.5f * d1 * (1.f + erff(d1 * 0.70710678118f));
      if (l16 == 0) { COEF[(size_t)m * 128 + s0] = sg[s0] * a0; COEF[(size_t)m * 128 + s1] = sg[s1] * a1; }
#pragma unroll
      for (int c = 0; c < 8; c++) cur[c] = nxt[c];
    }
    __syncthreads();
  }
  return;
  }
  for (int m = blockIdx.x * 4 + w; m < M; m += gridDim.x * 4) {
    {
      int2 e2 = *(const int2*)(EIDX + (size_t)m * 128 + lane * 2);
      float2 c2 = *(const float2*)(COEF + (size_t)m * 128 + lane * 2);
      *(int2*)(se + lane * 2) = e2; *(float2*)(coefs + lane * 2) = c2;
    }
    u32x4 cur[8], nxt[8];
    __syncthreads();
    f32x2 acc[32];
#pragma unroll
    for (int i = 0; i < 32; i++) acc[i] = (f32x2){0.f, 0.f};
    {
      const unsigned char* r0p = V + (size_t)se[g] * 1024 + l16 * 16;
      const unsigned char* r1p = V + (size_t)se[4 + g] * 1024 + l16 * 16;
#pragma unroll
      for (int c = 0; c < 4; c++) { cur[c] = *(const u32x4*)(r0p + c * 256); cur[4 + c] = *(const u32x4*)(r1p + c * 256); }
    }
#pragma unroll 2
    for (int st = 0; st < 16; st++) {
      if (st + 1 < 16) {
        const unsigned char* r0p = V + (size_t)se[(st + 1) * 8 + g] * 1024 + l16 * 16;
        const unsigned char* r1p = V + (size_t)se[(st + 1) * 8 + 4 + g] * 1024 + l16 * 16;
#pragma unroll
        for (int c = 0; c < 4; c++) { nxt[c] = *(const u32x4*)(r0p + c * 256); nxt[4 + c] = *(const u32x4*)(r1p + c * 256); }
      }
      const float c0 = coefs[st * 8 + g], c1 = coefs[st * 8 + 4 + g];
      const f32x2 ca = (f32x2){c0, c0}, cb = (f32x2){c1, c1};
#pragma unroll
      for (int c = 0; c < 4; c++) {
#pragma unroll
        for (int d = 0; d < 4; d++) {
          acc[c * 8 + d * 2 + 0] += ca * __builtin_amdgcn_cvt_pk_f32_fp8((int)cur[c][d], false);
          acc[c * 8 + d * 2 + 1] += ca * __builtin_amdgcn_cvt_pk_f32_fp8((int)cur[c][d], true);
          acc[c * 8 + d * 2 + 0] += cb * __builtin_amdgcn_cvt_pk_f32_fp8((int)cur[4 + c][d], false);
          acc[c * 8 + d * 2 + 1] += cb * __builtin_amdgcn_cvt_pk_f32_fp8((int)cur[4 + c][d], true);
        }
      }
#pragma unroll
      for (int c = 0; c < 8; c++) cur[c] = nxt[c];
    }
    __syncthreads();
#pragma unroll
    for (int i = 0; i < 32; i++) {
      acc[i].x += __shfl_xor(acc[i].x, 16); acc[i].x += __shfl_xor(acc[i].x, 32);
      acc[i].y += __shfl_xor(acc[i].y, 16); acc[i].y += __shfl_xor(acc[i].y, 32);
    }
    const int mr = (m < MM) ? (m >> 13) : 2;
    const float* m5 = mod + (size_t)mr * 6144 + 5 * 1024;
    float xn[16];
#pragma unroll
    for (int c = 0; c < 4; c++) {
      if (c == g) {
#pragma unroll
        for (int i = 0; i < 8; i++) { xn[2 * i] = acc[c * 8 + i].x; xn[2 * i + 1] = acc[c * 8 + i].y; }
      }
    }
    const int col = g * 256 + l16 * 16;
    float ss = 0.f;
#pragma unroll
    for (int q = 0; q < 4; q++) {
      float4 xa = *(const float4*)(X + (size_t)m * 1024 + col + q * 4);
      float4 ma = *(const float4*)(m5 + col + q * 4);
      xn[q * 4 + 0] = xa.x + ma.x * xn[q * 4 + 0]; xn[q * 4 + 1] = xa.y + ma.y * xn[q * 4 + 1];
      xn[q * 4 + 2] = xa.z + ma.z * xn[q * 4 + 2]; xn[q * 4 + 3] = xa.w + ma.w * xn[q * 4 + 3];
    }
#pragma unroll
    for (int i = 0; i < 16; i++) ss += xn[i] * xn[i];
    if (!final_) {
#pragma unroll
      for (int q = 0; q < 4; q++)
        *(float4*)(X + (size_t)m * 1024 + col + q * 4) = make_float4(xn[q * 4 + 0], xn[q * 4 + 1], xn[q * 4 + 2], xn[q * 4 + 3]);
      ss = wave_sum(ss);
      const float rinv = rsqrtf(ss * (1.f / 1024.f) + 1e-6f);
      const float* ng = p.in[I_N1G] + (layer + 1) * 1024;
      const float* nmod = WSP(float, S_MOD) + (size_t)(layer + 1) * 3 * 6144 + (size_t)mr * 6144;
      unsigned hv[8];
#pragma unroll
      for (int q = 0; q < 4; q++) {
        float4 g4 = *(const float4*)(ng + col + q * 4), sh = *(const float4*)(nmod + col + q * 4), sc = *(const float4*)(nmod + 1024 + col + q * 4);
        hv[q * 2 + 0] = pack2(xn[q * 4 + 0] * rinv * g4.x * (1.f + sc.x) + sh.x, xn[q * 4 + 1] * rinv * g4.y * (1.f + sc.y) + sh.y);
        hv[q * 2 + 1] = pack2(xn[q * 4 + 2] * rinv * g4.z * (1.f + sc.z) + sh.z, xn[q * 4 + 3] * rinv * g4.w * (1.f + sc.w) + sh.w);
      }
      bf16_t* hw = WSP(bf16_t, OFF_H) + (size_t)m * LDH + col;
      *(uint4*)(hw) = make_uint4(hv[0], hv[1], hv[2], hv[3]);
      *(uint4*)(hw + 8) = make_uint4(hv[4], hv[5], hv[6], hv[7]);
    } else {
      ss = wave_sum(ss);
      const float rinv = rsqrtf(ss * (1.f / 1024.f) + 1e-6f);
      const float* fg = p.in[I_FNG];
#pragma unroll
      for (int q = 0; q < 4; q++) {
        float4 g4 = *(const float4*)(fg + col + q * 4);
        *(float4*)(p.out + (size_t)m * 1024 + col + q * 4) = make_float4(xn[q * 4 + 0] * rinv * g4.x, xn[q * 4 + 1] * rinv * g4.y, xn[q * 4 + 2] * rinv * g4.z, xn[q * 4 + 3] * rinv * g4.w);
      }
    }
  }
}

struct EpiHG {
  bf16_t* QH; bf16_t* LF; bf16_t* LB; bf16_t* IH; bf16_t* GH; const float* lbp;
  DEV void operator()(int m, int n, f32x4 v) {
    const int seg = n >> 10, c = n & 1023;
    bf16_t* dst;
    if (seg == 0) dst = QH; else if (seg == 1) dst = LF; else if (seg == 2) dst = LB; else if (seg == 3) dst = IH; else dst = GH;
    if (seg == 1 || seg == 2) {
      const int dir = seg - 1;
#pragma unroll
      for (int r = 0; r < 4; r++) {
        float lb = sigm(lbp[(2 + dir) * 1024 + c + r] - lbp[dir * 1024 + c + r]);
        float ff = lb + (1.f - lb) * sigm(v[r]);
        v[r] = __logf(ff);
      }
    }
    uint2 o; o.x = pack2(v[0], v[1]); o.y = pack2(v[2], v[3]);
    *(uint2*)(dst + (size_t)m * 1024 + c) = o;
  }
};
DEV void phase_gemm_hgin(const Params& p, char* smem) {
  EpiHG epi{WSP(bf16_t, L1_QH), WSP(bf16_t, L1_LF), WSP(bf16_t, L1_LB), WSP(bf16_t, L1_IH), WSP(bf16_t, L1_GH), p.in[I_HGLB]};
  const int items = (MT / 128) * 40;
  for (int item = blockIdx.x; item < items; item += gridDim.x) {
    int mt = item / 40, nt = item - mt * 40;
    gemm_tile(WSP(bf16_t, OFF_H), LDH, WSP(bf16_t, S_WHGIN), LDH, 1024, mt * 128, nt * 128, epi, smem);
  }
}

DEV int hg_row0(int cidx, int b) { return (cidx < 4) ? (MM + b * 256 + cidx * 64) : (b * 8192 + (cidx - 4) * 64); }
DEV int hg_step(int cidx, int dir) {
  if (dir == 0) return cidx;
  return (cidx < 4) ? (3 - cidx) : (4 + 127 - (cidx - 4));
}

DEV void phase_hg_c1(const Params& p, char* smem) {
  const bf16_t* LFp = WSP(bf16_t, L1_LF); const bf16_t* LBp = WSP(bf16_t, L1_LB); const bf16_t* IH = WSP(bf16_t, L1_IH);
  bf16_t* DS = WSP(bf16_t, L1_DS); float* DEC = WSP(float, S_DECAY);
  bf16_t* RA = (bf16_t*)smem;
  bf16_t* RB = RA + 128 * 80;
  bf16_t* Vt = RB + 128 * 80;
  float* tot = (float*)(Vt + 128 * 80);
  const int tid = tidx(), lane = tid & 63, w = tid >> 6, l15 = lane & 15, quad = lane >> 4;
  const int wm = w >> 1, wn = w & 1;
  const int k = tid & 127, half = tid >> 7;
  const int items = 132 * 16;
  for (int item = blockIdx.x; item < items; item += gridDim.x) {
    const int cidx = item >> 4, bh = item & 15, b = bh >> 3, h = bh & 7;
    const int r0 = hg_row0(cidx, b);
    __syncthreads();
#pragma unroll
    for (int i = 0; i < 4; i++) {
      int id = tid + i * 256; int s = id >> 4, cc = id & 15;
      uint4 u = *(const uint4*)(IH + (size_t)(r0 + s) * 1024 + h * 128 + cc * 8);
      uint4 lf = *(const uint4*)(LFp + (size_t)(r0 + s) * 1024 + h * 128 + cc * 8);
      *(uint4*)(RB + s * 144 + cc * 8) = lf;
      bf16_t* vt = Vt + (cc * 8) * 80 + s;
      vt[0] = (bf16_t)(u.x & 0xffff); vt[80] = (bf16_t)(u.x >> 16); vt[160] = (bf16_t)(u.y & 0xffff); vt[240] = (bf16_t)(u.y >> 16);
      vt[320] = (bf16_t)(u.z & 0xffff); vt[400] = (bf16_t)(u.z >> 16); vt[480] = (bf16_t)(u.w & 0xffff); vt[560] = (bf16_t)(u.w >> 16);
    }
#pragma unroll 1
    for (int dir = 0; dir < 2; dir++) {
      bf16_t* stg = dir ? RA : RB;
      bf16_t* kot = dir ? RB : RA;
      if (dir == 1) {
        __syncthreads();
#pragma unroll
        for (int i = 0; i < 4; i++) {
          int id = tid + i * 256; int s = id >> 4, cc = id & 15;
          *(uint4*)(RA + s * 144 + cc * 8) = *(const uint4*)(LBp + (size_t)(r0 + s) * 1024 + h * 128 + cc * 8);
        }
      }
      __syncthreads();
      {
        float t = 0.f;
#pragma unroll 8
        for (int s = 0; s < 32; s++) t += bf2f(stg[(half * 32 + s) * 144 + k]);
        tot[half * 128 + k] = t;
      }
      __syncthreads();
      {
        const float tot0 = tot[k], total = tot0 + tot[128 + k];
        float run = half ? tot0 : 0.f;
        float lfr[32];
#pragma unroll
        for (int s = 0; s < 32; s++) lfr[s] = bf2f(stg[(half * 32 + s) * 144 + k]);
        if (dir == 1) __syncthreads();
        bf16_t* ko = kot + k * 80 + half * 32;
#pragma unroll
        for (int s2 = 0; s2 < 32; s2 += 2) {
          float o2[2];
#pragma unroll
          for (int u = 0; u < 2; u++) {
            const float lf = lfr[s2 + u];
            const float kk = 1.f - __expf(lf);
            float ex;
            if (dir == 0) { run += lf; ex = total - run; } else { ex = run; run += lf; }
            o2[u] = kk * __expf(ex);
          }
          *(unsigned*)(ko + s2) = pack2(o2[0], o2[1]);
        }
        if (half == 0) DEC[((size_t)(bh * 2 + dir) * 132 + hg_step(cidx, dir)) * 128 + k] = __expf(total);
      }
      __syncthreads();
      f32x4 acc[4][4];
#pragma unroll
      for (int i = 0; i < 4; i++)
#pragma unroll
        for (int j = 0; j < 4; j++) acc[i][j] = (f32x4){0.f, 0.f, 0.f, 0.f};
      mfma_lds<4, 4, 2>(kot, 80, Vt, 80, wm * 64, wn * 64, acc);
      bf16_t* dst = DS + ((size_t)(bh * 2 + dir) * 132 + hg_step(cidx, dir)) * 16384;
#pragma unroll
      for (int i = 0; i < 4; i++)
#pragma unroll
        for (int j = 0; j < 4; j++) {
          int kk = wm * 64 + i * 16 + quad * 4, dv = wn * 64 + j * 16 + l15;
          uint2 o; o.x = pack2(acc[i][j][0], acc[i][j][1]); o.y = pack2(acc[i][j][2], acc[i][j][3]);
          *(uint2*)(dst + dv * 128 + kk) = o;
        }
    }
  }
}

DEV void phase_hg_c2(const Params& p) {
  bf16_t* DS = WSP(bf16_t, L1_DS); const float* DEC = WSP(float, S_DECAY);
  for (int idx = blockIdx.x * 256 + tidx(); idx < 32 * 128 * 32; idx += gridDim.x * 256) {
    const int k4 = idx & 31, dv = (idx >> 5) & 127, chain = idx >> 12;
    bf16_t* dp = DS + (size_t)chain * 132 * 16384 + dv * 128 + k4 * 4;
    const float* dc = DEC + (size_t)chain * 132 * 128 + k4 * 4;
    float s0 = 0.f, s1 = 0.f, s2 = 0.f, s3 = 0.f;
    for (int st = 0; st < 132; st += 4) {
      uint2 d[4]; float4 dd[4];
#pragma unroll
      for (int u = 0; u < 4; u++) { d[u] = *(const uint2*)(dp + (size_t)(st + u) * 16384); dd[u] = *(const float4*)(dc + (size_t)(st + u) * 128); }
#pragma unroll
      for (int u = 0; u < 4; u++) {
        uint2 o; o.x = pack2(s0, s1); o.y = pack2(s2, s3);
        *(uint2*)(dp + (size_t)(st + u) * 16384) = o;
        s0 = dd[u].x * s0 + bflo(d[u].x); s1 = dd[u].y * s1 + bfhi(d[u].x);
        s2 = dd[u].z * s2 + bflo(d[u].y); s3 = dd[u].w * s3 + bfhi(d[u].y);
      }
    }
  }
}

DEV void phase_hg_c3(const Params& p, char* smem) {
  const bf16_t* QH = WSP(bf16_t, L1_QH); const bf16_t* LFp = WSP(bf16_t, L1_LF); const bf16_t* LBp = WSP(bf16_t, L1_LB);
  const bf16_t* IH = WSP(bf16_t, L1_IH); const bf16_t* GH = WSP(bf16_t, L1_GH); const bf16_t* DS = WSP(bf16_t, L1_DS);
  bf16_t* Rout = WSP(bf16_t, OFF_H);
  bf16_t* Qin = (bf16_t*)smem;
  bf16_t* Kin = Qin + 64 * 144;
  bf16_t* Vt = Kin + 64 * 144;
  bf16_t* Am = Vt + 128 * 80;
  bf16_t* SpT = Kin;
  float* Ob = (float*)smem;
  float* tot = (float*)(Am);
  const int tid = tidx(), lane = tid & 63, w = tid >> 6, l15 = lane & 15, quad = lane >> 4;
  const int wm = w >> 1, wn = w & 1;
  const int items = 128 * 16;
  for (int item = blockIdx.x; item < items; item += gridDim.x) {
    const int c = item >> 4, bh = item & 15, b = bh >> 3, h = bh & 7;
    const int cidx = c + 4;
    const int r0 = b * 8192 + c * 64;
    f32x4 acc[2][4];
#pragma unroll
    for (int i = 0; i < 2; i++)
#pragma unroll
      for (int j = 0; j < 4; j++) acc[i][j] = (f32x4){0.f, 0.f, 0.f, 0.f};
#pragma unroll 1
    for (int dir = 0; dir < 2; dir++) {
      __syncthreads();
      const int k = tid & 127, half = tid >> 7;
      {
        const bf16_t* lsrc = (dir ? LBp : LFp);
#pragma unroll
        for (int i = 0; i < 4; i++) {
          int id = tid + i * 256; int s = id >> 4, cc = id & 15;
          const size_t go = (size_t)(r0 + s) * 1024 + h * 128 + cc * 8;
          uint4 u = *(const uint4*)(IH + go);
          *(uint4*)(Kin + s * 144 + cc * 8) = *(const uint4*)(lsrc + go);
          *(uint4*)(Qin + s * 144 + cc * 8) = *(const uint4*)(QH + go);
          bf16_t* vt = Vt + (cc * 8) * 80 + s;
          vt[0] = (bf16_t)(u.x & 0xffff); vt[80] = (bf16_t)(u.x >> 16); vt[160] = (bf16_t)(u.y & 0xffff); vt[240] = (bf16_t)(u.y >> 16);
          vt[320] = (bf16_t)(u.z & 0xffff); vt[400] = (bf16_t)(u.z >> 16); vt[480] = (bf16_t)(u.w & 0xffff); vt[560] = (bf16_t)(u.w >> 16);
        }
      }
      u32x4 spr[8];
      {
        const bf16_t* sp = DS + ((size_t)(bh * 2 + dir) * 132 + hg_step(cidx, dir)) * 16384;
#pragma unroll
        for (int i = 0; i < 8; i++) { int id = tid + i * 256; int row = id >> 4, cc = id & 15; spr[i] = *(const u32x4*)(sp + row * 128 + cc * 8); }
      }
      __syncthreads();
      {
        float t = 0.f;
#pragma unroll 8
        for (int s = 0; s < 32; s++) t += bf2f(Kin[(half * 32 + s) * 144 + k]);
        tot[half * 128 + k] = t;
      }
      __syncthreads();
      if (dir == 0) {
        float run = half ? tot[k] : 0.f;
#pragma unroll 4
        for (int s = 0; s < 32; s++) {
          const int t = half * 32 + s;
          const float lf = bf2f(Kin[t * 144 + k]); run += lf;
          const float q = bf2f(Qin[t * 144 + k]);
          Qin[t * 144 + k] = f2bf(q * __expf(run));
          Kin[t * 144 + k] = f2bf((1.f - __expf(lf)) * __expf(-run));
        }
      } else {
        float run = half ? 0.f : tot[128 + k];
#pragma unroll 4
        for (int s = 31; s >= 0; s--) {
          const int t = half * 32 + s;
          const float lf = bf2f(Kin[t * 144 + k]); run += lf;
          const float q = bf2f(Qin[t * 144 + k]);
          Qin[t * 144 + k] = f2bf(q * __expf(run));
          Kin[t * 144 + k] = f2bf((1.f - __expf(lf)) * __expf(-run));
        }
      }
      __syncthreads();
      {
        f32x4 aa[2][2];
#pragma unroll
        for (int i = 0; i < 2; i++) { aa[i][0] = (f32x4){0.f, 0.f, 0.f, 0.f}; aa[i][1] = (f32x4){0.f, 0.f, 0.f, 0.f}; }
        mfma_lds<2, 2, 4>(Qin, 144, Kin, 144, wm * 32, wn * 32, aa);
#pragma unroll
        for (int i = 0; i < 2; i++)
#pragma unroll
          for (int j = 0; j < 2; j++)
#pragma unroll
            for (int r = 0; r < 4; r++) {
              int t = wm * 32 + i * 16 + quad * 4 + r, s = wn * 32 + j * 16 + l15;
              bool keep = dir ? (s >= t) : (s <= t);
              Am[t * 80 + s] = f2bf(keep ? aa[i][j][r] : 0.f);
            }
      }
      __syncthreads();
      mfma_lds<2, 4, 2>(Am, 80, Vt, 80, wm * 32, wn * 64, acc);
      __syncthreads();
#pragma unroll
      for (int i = 0; i < 8; i++) { int id = tid + i * 256; int row = id >> 4, cc = id & 15; *(u32x4*)(SpT + row * 144 + cc * 8) = spr[i]; }
      __syncthreads();
      mfma_lds<2, 4, 4>(Qin, 144, SpT, 144, wm * 32, wn * 64, acc);
    }
    __syncthreads();
#pragma unroll
    for (int i = 0; i < 2; i++)
#pragma unroll
      for (int j = 0; j < 4; j++)
#pragma unroll
        for (int r = 0; r < 4; r++) Ob[(wm * 32 + i * 16 + quad * 4 + r) * 132 + wn * 64 + j * 16 + l15] = acc[i][j][r];
    __syncthreads();
    {
      const int t = tid >> 2, q4 = tid & 3;
      float vals[32]; float ss = 0.f;
#pragma unroll
      for (int j = 0; j < 4; j++) {
        const int dv = (j * 4 + q4) * 8;
        float4 a = *(const float4*)(Ob + t * 132 + dv), bq = *(const float4*)(Ob + t * 132 + dv + 4);
        vals[j * 8 + 0] = a.x; vals[j * 8 + 1] = a.y; vals[j * 8 + 2] = a.z; vals[j * 8 + 3] = a.w;
        vals[j * 8 + 4] = bq.x; vals[j * 8 + 5] = bq.y; vals[j * 8 + 6] = bq.z; vals[j * 8 + 7] = bq.w;
      }
#pragma unroll
      for (int i = 0; i < 32; i++) ss += vals[i] * vals[i];
      ss += __shfl_xor(ss, 1); ss += __shfl_xor(ss, 2);
      const float rinv = rsqrtf(ss * (1.f / 128.f) + 1e-6f);
      const float* ng = p.in[I_HGNG];
#pragma unroll
      for (int j = 0; j < 4; j++) {
        const int col = h * 128 + (j * 4 + q4) * 8;
        uint4 gu = *(const uint4*)(GH + (size_t)(r0 + t) * 1024 + col);
        float4 na = *(const float4*)(ng + col), nb = *(const float4*)(ng + col + 4);
        float g0 = bflo(gu.x), g1 = bfhi(gu.x), g2 = bflo(gu.y), g3 = bfhi(gu.y), g4 = bflo(gu.z), g5 = bfhi(gu.z), g6 = bflo(gu.w), g7 = bfhi(gu.w);
        uint4 o;
        o.x = pack2(vals[j * 8 + 0] * rinv * na.x * g0 * sigm(g0), vals[j * 8 + 1] * rinv * na.y * g1 * sigm(g1));
        o.y = pack2(vals[j * 8 + 2] * rinv * na.z * g2 * sigm(g2), vals[j * 8 + 3] * rinv * na.w * g3 * sigm(g3));
        o.z = pack2(vals[j * 8 + 4] * rinv * nb.x * g4 * sigm(g4), vals[j * 8 + 5] * rinv * nb.y * g5 * sigm(g5));
        o.w = pack2(vals[j * 8 + 6] * rinv * nb.z * g6 * sigm(g6), vals[j * 8 + 7] * rinv * nb.w * g7 * sigm(g7));
        *(uint4*)(Rout + (size_t)(r0 + t) * LDH + col) = o;
      }
    }
  }
}


#define XB_TMO      128
#define XB_XCNT(j)  (256  + 64 * (j))
#define XB_XSUB(j)  (1280 + 64 * (j))
#define XB_XGEN(j)  (2304 + 64 * (j))
#define XB_TOP      3328
#define XB_TOPGEN   3392
#define XCD_BAR_WORDS 3456
#define XB_SPIN_CAP (1u << 22)
#define LAS __attribute__((address_space(3)))
DEV unsigned xb_ld(unsigned* p) { return __hip_atomic_load(p, __ATOMIC_RELAXED, __HIP_MEMORY_SCOPE_AGENT); }
DEV unsigned xb_add(unsigned* p, unsigned v) { return __hip_atomic_fetch_add(p, v, __ATOMIC_RELAXED, __HIP_MEMORY_SCOPE_AGENT); }
DEV unsigned xb_xcc_id() { return (unsigned)__builtin_amdgcn_s_getreg((3 << 11) | 20) & 0xFu; }
#define XB_SPIN(cond, bar) do { unsigned _sp = 0; while (cond) { __builtin_amdgcn_s_sleep(1); \
    if ((++_sp & 255u) == 0u) { if (xb_ld(&(bar)[XB_TMO])) break; if (_sp > XB_SPIN_CAP) { atomicAdd(&(bar)[XB_TMO], 1u); break; } } } } while (0)
struct XcdBarrier { unsigned* bar; unsigned x; volatile LAS unsigned* st; };
DEV XcdBarrier xcd_barrier_post(unsigned* bar, volatile LAS unsigned* st) {
  XcdBarrier b; b.bar = bar; b.x = xb_xcc_id(); b.st = st;
  if (threadIdx.x == 0) (void)xb_add(&bar[XB_XCNT(b.x)], 1u);
  return b;
}
DEV void xcd_barrier_complete(unsigned* bar, unsigned x, unsigned& nloc, unsigned& nx) {
  const unsigned G = gridDim.x * gridDim.y * gridDim.z;
  unsigned sum, cnt, mine, sp = 0u;
  for (;;) {
    sum = 0u; cnt = 0u; mine = 0u;
#pragma unroll
    for (unsigned j = 0; j < 16; ++j) { const unsigned c = xb_ld(&bar[XB_XCNT(j)]); sum += c; cnt += (c > 0u) ? 1u : 0u; mine = (j == x) ? c : mine; }
    if (sum == G) break;
    __builtin_amdgcn_s_sleep(1);
    if ((++sp & 255u) == 0u) { if (xb_ld(&bar[XB_TMO])) break; if (sp > XB_SPIN_CAP) { atomicAdd(&bar[XB_TMO], 1u); break; } }
  }
  nloc = mine > 0u ? mine : 1u; nx = cnt > 0u ? cnt : 1u;
}
DEV void xcd_barrier(const XcdBarrier& b) {
  asm volatile("s_waitcnt vmcnt(0)" ::: "memory");
  __syncthreads();
  if (threadIdx.x == 0) {
    unsigned* bar = b.bar;
    __builtin_amdgcn_s_waitcnt(0);
    unsigned nloc = b.st[0], nx = b.st[1];
    if (nloc == 0u) { xcd_barrier_complete(bar, b.x, nloc, nx); b.st[0] = nloc; b.st[1] = nx; }
    const unsigned old = xb_add(&bar[XB_XSUB(b.x)], 1u);
    const unsigned gen = old / nloc;
    if (old + 1u == (gen + 1u) * nloc) {
      __builtin_amdgcn_fence(__ATOMIC_RELEASE, "agent");
      asm volatile("s_waitcnt vmcnt(0)" ::: "memory");
      const unsigned og = xb_add(&bar[XB_TOP], 1u);
      const unsigned tg = og / nx;
      if (og + 1u == (tg + 1u) * nx) xb_add(&bar[XB_TOPGEN], 1u);
      else XB_SPIN(xb_ld(&bar[XB_TOPGEN]) == tg, bar);
      __builtin_amdgcn_fence(__ATOMIC_ACQUIRE, "agent");
      xb_add(&bar[XB_XGEN(b.x)], 1u);
      asm volatile("s_waitcnt vmcnt(0)" ::: "memory");
    } else {
      XB_SPIN(xb_ld(&bar[XB_XGEN(b.x)]) == gen, bar);
      __builtin_amdgcn_fence(__ATOMIC_ACQUIRE, "agent");
      asm volatile("s_waitcnt vmcnt(0)" ::: "memory");
    }
  }
  __syncthreads();
}

#define NPHASE 21
#define SMEM_BYTES 80896
#define TAB_OFF 80640
DEV void park_params(const Params& p, char* smem) {
  if (tidx() == 0) {
    unsigned long long* tab = (unsigned long long*)(smem + TAB_OFF);
#pragma unroll
    for (int i = 0; i < 27; i++) tab[i] = (unsigned long long)p.in[i];
    tab[27] = (unsigned long long)p.ws;
    tab[28] = (unsigned long long)p.out;
  }
  __syncthreads();
}
DEV unsigned long long tab_get(const char* smem, int i) {
  const unsigned* t = (const unsigned*)(smem + TAB_OFF) + 2 * i;
  unsigned lo = __builtin_amdgcn_readfirstlane(t[0]), hi = __builtin_amdgcn_readfirstlane(t[1]);
  return ((unsigned long long)hi << 32) | lo;
}
typedef __attribute__((address_space(1))) char gchar_t;
DEV void fetch_params(Params& q, const char* smem) {
#pragma unroll
  for (int i = 0; i < 27; i++) q.in[i] = (const float*)(char*)(gchar_t*)tab_get(smem, i);
  q.ws = (char*)(gchar_t*)tab_get(smem, 27);
  q.out = (float*)(char*)(gchar_t*)tab_get(smem, 28);
}
DEV void run_phase(int ph, char* smem) {
#ifdef ONLYPH
  if (ph != ONLYPH) return;
#endif
  Params p;
  fetch_params(p, smem);
  switch (ph) {
    case 0: phase_prep(p, smem); break;
    case 1: phase_norm(p, 0, 0, MT, true); break;
    case 2: phase_gemm_win(p, smem); break;
    case 3: phase_post1(p); break;
    case 4: phase_qkv_conv(p, smem); break;
    case 5: phase_attn(p, smem); break;
    case 6: phase_gemm_out(p, 0, smem); break;
    case 7: phase_norm(p, 0, 1, MT, false); break;
    case 8: phase_gemm_pq(p, 0, MT, smem); break;
    case 9: phase_peer_score(p, 0, MT, smem); break;
    case 10: phase_peer_expert(p, 0, MT, false, 1, smem); break;
    case 110: phase_peer_expert(p, 0, MT, false, 0, smem); break;
    case 11: break;
    case 12: phase_gemm_hgin(p, smem); break;
    case 13: phase_hg_c1(p, smem); break;
    case 14: phase_hg_c2(p); break;
    case 15: phase_hg_c3(p, smem); break;
    case 16: phase_gemm_out(p, 1, smem); break;
    case 17: phase_norm(p, 1, 1, MM, false); break;
    case 18: phase_gemm_pq(p, 1, MM, smem); break;
    case 19: phase_peer_score(p, 1, MM, smem); break;
    case 20: phase_peer_expert(p, 1, MM, true, 1, smem); break;
    case 120: phase_peer_expert(p, 1, MM, true, 0, smem); break;
    default: break;
  }
}

#if MEGA
#define OFF_BAR (492 * MIB)
__global__ void __launch_bounds__(256, 2) fwd_megakernel(Params p) {
  __shared__ __attribute__((aligned(16))) char smem[SMEM_BYTES];
  __shared__ uint4 xb_words;
  cg::grid_group grid = cg::this_grid();
  if (threadIdx.x == 0) xb_words = make_uint4(0u, 0u, 0u, 0u);
  park_params(p, smem);
  XcdBarrier xb = xcd_barrier_post((unsigned*)(p.ws + OFF_BAR), (volatile LAS unsigned*)&xb_words);
#pragma unroll 1
  for (int ph = 0; ph < NPHASE; ph++) {
    if (ph == 11) continue;
    if (ph == 10 || ph == 20) { run_phase(ph + 100, smem); xcd_barrier(xb); }
    run_phase(ph, smem);
    if (ph + 1 < NPHASE) xcd_barrier(xb);
    if (p.ws == nullptr) grid.sync();
  }
}
#else
__global__ void __launch_bounds__(256, 2) fwd_phase(Params p, int ph) {
  __shared__ __attribute__((aligned(16))) char smem[SMEM_BYTES];
  park_params(p, smem);
  run_phase(ph, smem);
}
#endif

extern "C" void kernel_launch(void* const* d_in, const int* in_sizes, int n_in, void* d_out, int out_size, void* d_ws,
                              size_t ws_size, hipStream_t stream) {
  Params p{};
  for (int i = 0; i < 27; i++) p.in[i] = (const float*)d_in[i];
  p.ws = (char*)d_ws;
  p.out = (float*)d_out;
  if (ws_size < WS_NEED) { fprintf(stderr, "workspace too small: %zu\n", ws_size); return; }
#if MEGA
  static int grid_blocks = 0;
  if (!grid_blocks) {
    int dev = 0, cus = 0, per_cu = 0;
    hipGetDevice(&dev);
    hipDeviceGetAttribute(&cus, hipDeviceAttributeMultiprocessorCount, dev);
    hipOccupancyMaxActiveBlocksPerMultiprocessor(&per_cu, fwd_megakernel, 256, 0);
    if (per_cu > 2) per_cu = 2;
    grid_blocks = cus * per_cu;
  }
  hipMemsetAsync((char*)d_ws + OFF_BAR, 0, XCD_BAR_WORDS * 4, stream);
  void* args[] = {&p};
  hipError_t e = hipLaunchCooperativeKernel((void*)fwd_megakernel, dim3(grid_blocks), dim3(256), args, 0, stream);
  if (e != hipSuccess) fprintf(stderr, "cooperative launch failed: %s (grid %d)\n", hipGetErrorString(e), grid_blocks);
#else
  for (int ph = 0; ph < NPHASE; ph++) fwd_phase<<<dim3(1024), dim3(256), 0, stream>>>(p, ph);
#endif
}
```

```cpp
#include <hip/hip_runtime.h>
#include <hip/hip_cooperative_groups.h>
#include <stdint.h>
#include <stdio.h>
namespace cg = cooperative_groups;

#ifndef MEGA
#define MEGA 1
#endif

typedef unsigned short bf16_t;
typedef __attribute__((ext_vector_type(8))) short bf16x8;
typedef __attribute__((ext_vector_type(4))) float f32x4;
typedef __attribute__((ext_vector_type(2))) __bf16 bf2_t;
typedef __attribute__((ext_vector_type(4))) unsigned u32x4;
typedef __attribute__((ext_vector_type(2))) float f32x2;

#define DEV __device__ __forceinline__
#define MM 16384
#define MT 16896
#define MIB ((size_t)1 << 20)

#define OFF_X     ((size_t)0)
#define OFF_H     (66 * MIB)
#define OFF_U1    (103 * MIB)
#define OFF_V1    (131 * MIB)
#define OFF_SMALL (163 * MIB)
#define OFF_U0    (195 * MIB)
#define OFF_V0    (227 * MIB)
#define OFF_R     (259 * MIB)
#define LDH 1088
#define QMIB ((size_t)262144)
#define S_WIN0   (OFF_SMALL)
#define S_WUQ    (OFF_SMALL + 13 * QMIB)
#define S_WUKV   (OFF_SMALL + 13 * QMIB + 393216)
#define S_WOUT0  (OFF_SMALL + 15 * QMIB + 131072)
#define S_WHGIN  (OFF_SMALL + 24 * QMIB)
#define S_WHGOUT (OFF_SMALL + 66 * QMIB + 131072)
#define S_WPQ    (OFF_SMALL + 75 * QMIB)
#define S_SUBK   (OFF_SMALL + 109 * QMIB)
#define S_MOD    (OFF_SMALL + 113 * QMIB)
#define S_ROPEC  (OFF_SMALL + 114 * QMIB)
#define S_ROPES  (OFF_SMALL + 116 * QMIB)
#define S_DECAY  (OFF_SMALL + 118 * QMIB)
#define S_UVSC   (OFF_SMALL + 126 * QMIB + 131072)
#define R_P0   (OFF_R)
#define R_QN   (OFF_R + 50 * MIB)
#define R_KVN  (OFF_R + 59 * MIB)
#define R_YG   (OFF_R + 64 * MIB)
#define R_Q    (OFF_R + 81 * MIB)
#define R_QC   (OFF_R + 105 * MIB)
#define R_K    (OFF_R + 106 * MIB)
#define R_VT   (OFF_R + 131 * MIB)
#define R_MIX  (OFF_R + 148 * MIB)
#define R_EIDX (OFF_R + 184 * MIB)
#define R_GATE (OFF_R + 193 * MIB)
#define R_COEF (OFF_R + 210 * MIB)
#define R_PQ   (OFF_R)
#define L1_QH   (195 * MIB)
#define L1_LF   (228 * MIB)
#define L1_LB   (261 * MIB)
#define L1_IH   (294 * MIB)
#define L1_GH   (327 * MIB)
#define L1_DS   (360 * MIB)
#define L1_PQ   (195 * MIB)
#define L1_EIDX (261 * MIB)
#define L1_GATE (270 * MIB)
#define L1_COEF (287 * MIB)
#define WS_NEED (493 * MIB)

struct Params {
  const float* in[27];
  char* ws;
  float* out;
};
#define WSP(type, off) ((type*)(p.ws + (size_t)(off)))

enum { I_X = 0, I_C, I_CTX, I_CCTX, I_ADAW, I_ADAB, I_N1G, I_N2G, I_WIN, I_QG, I_WUQ, I_KVG, I_WUKV, I_CONVW, I_CONVB,
       I_LNG, I_LNB, I_WOUT, I_HGWIN, I_HGLB, I_HGNG, I_HGWOUT, I_PWQ, I_PSK, I_PU, I_PV, I_FNG };

DEV int tidx() { int t = threadIdx.x; asm volatile("" : "+v"(t)); return t; }
DEV unsigned short f2bf(float x) { return __builtin_bit_cast(unsigned short, (__bf16)x); }
DEV float bf2f(unsigned short b) { return __uint_as_float(((unsigned)b) << 16); }
DEV unsigned pack2(float a, float b) { f32x2 v = {a, b}; return __builtin_bit_cast(unsigned, __builtin_convertvector(v, bf2_t)); }
DEV float bflo(unsigned u) { return __uint_as_float(u << 16); }
DEV float bfhi(unsigned u) { return __uint_as_float(u & 0xffff0000u); }
DEV float wave_sum(float v) {
#pragma unroll
  for (int o = 32; o > 0; o >>= 1) v += __shfl_xor(v, o);
  return v;
}
DEV float sigm(float x) { return 1.f / (1.f + __expf(-x)); }
DEV f32x4 mfma16(bf16x8 a, bf16x8 b, f32x4 c) { return __builtin_amdgcn_mfma_f32_16x16x32_bf16(a, b, c, 0, 0, 0); }
DEV float dot2bf(unsigned a, unsigned b, float c) {
  return __builtin_amdgcn_fdot2_f32_bf16(__builtin_bit_cast(bf2_t, a), __builtin_bit_cast(bf2_t, b), c, false);
}

template <int TI, int TJ, int KS>
DEV void mfma_lds(const bf16_t* Arows, int lda, const bf16_t* Brows, int ldb, int i0, int j0, f32x4 (&acc)[TI][TJ]) {
  const int lane = tidx() & 63, l15 = lane & 15, quad = lane >> 4;
#pragma unroll
  for (int ks = 0; ks < KS; ks++) {
    bf16x8 af[TI], bfr[TJ];
#pragma unroll
    for (int i = 0; i < TI; i++) af[i] = *(const bf16x8*)(Arows + (i0 + i * 16 + l15) * lda + ks * 32 + quad * 8);
#pragma unroll
    for (int j = 0; j < TJ; j++) bfr[j] = *(const bf16x8*)(Brows + (j0 + j * 16 + l15) * ldb + ks * 32 + quad * 8);
#pragma unroll
    for (int i = 0; i < TI; i++)
#pragma unroll
      for (int j = 0; j < TJ; j++) acc[i][j] = mfma16(af[i], bfr[j], acc[i][j]);
  }
}

#define GLD 80
template <class Epi>
DEV void gemm_tile(const bf16_t* __restrict__ A, int lda, const bf16_t* __restrict__ Bt, int ldb, int K, int m0, int n0,
                   Epi& epi, char* smem) {
  bf16_t* As = (bf16_t*)smem;
  bf16_t* Bs = As + 128 * GLD;
  const int tid = tidx(), lane = tid & 63, w = tid >> 6, wm = w >> 1, wn = w & 1;
  const int l15 = lane & 15, quad = lane >> 4;
  f32x4 acc[4][4];
#pragma unroll
  for (int i = 0; i < 4; i++)
#pragma unroll
    for (int j = 0; j < 4; j++) acc[i][j] = (f32x4){0.f, 0.f, 0.f, 0.f};
  u32x4 ra0[4], rb0[4], ra1[4], rb1[4];
  const int nk = K >> 6;
  const int lrow = tid >> 3, lcc = tid & 7;
  const bf16_t* Ap = A + (size_t)(m0 + lrow) * lda + lcc * 8;
  const bf16_t* Bp = Bt + (size_t)(n0 + lrow) * ldb + lcc * 8;
#define G_LOAD(RA, RB, KT) { _Pragma("unroll") for (int i = 0; i < 4; i++) { \
      RA[i] = *(const u32x4*)(Ap + (size_t)(i * 32) * lda + (KT) * 64); RB[i] = *(const u32x4*)(Bp + (size_t)(i * 32) * ldb + (KT) * 64); } }
#define G_STORE(RA, RB) { _Pragma("unroll") for (int i = 0; i < 4; i++) { \
      *(u32x4*)(As + (lrow + i * 32) * GLD + lcc * 8) = RA[i]; *(u32x4*)(Bs + (lrow + i * 32) * GLD + lcc * 8) = RB[i]; } }
  G_LOAD(ra0, rb0, 0);
  G_LOAD(ra1, rb1, 1);
  for (int kt = 0; kt < nk; kt += 2) {
    __syncthreads();
    G_STORE(ra0, rb0);
    __syncthreads();
    if (kt + 2 < nk) G_LOAD(ra0, rb0, kt + 2);
    mfma_lds<4, 4, 2>(Bs, GLD, As, GLD, wn * 64, wm * 64, acc);
    __syncthreads();
    G_STORE(ra1, rb1);
    __syncthreads();
    if (kt + 3 < nk) G_LOAD(ra1, rb1, kt + 3);
    mfma_lds<4, 4, 2>(Bs, GLD, As, GLD, wn * 64, wm * 64, acc);
  }
#undef G_LOAD
#undef G_STORE
#pragma unroll
  for (int i = 0; i < 4; i++)
#pragma unroll
    for (int j = 0; j < 4; j++) epi(m0 + wm * 64 + j * 16 + l15, n0 + wn * 64 + i * 16 + quad * 4, acc[i][j]);
}


DEV bool xcd_tile(int item, int mtiles, int NT, int& mt, int& nt) {
  const int nng = NT >> 3;
  const int xcd = item & 7, j = item >> 3;
  const int group = (j >> 6) * 8 + xcd, within = j & 63;
  const int mg = group / nng, ng = group - mg * nng;
  mt = mg * 8 + (within >> 3); nt = ng * 8 + (within & 7);
  return mt < mtiles;
}
DEV int xcd_tile_items(int mtiles, int NT) { const int groups = ((mtiles + 7) >> 3) * (NT >> 3); return ((groups + 7) >> 3) * 8 * 64; }

DEV void transpose_tile(const float* __restrict__ W, int K, int N, bf16_t* __restrict__ Wt, int ldt, int tile, char* smem) {
  float* sm = (float*)smem;
  const int ntn = N >> 5;
  const int kt = tile / ntn, nt = tile - kt * ntn;
  const int tx = tidx() & 31, ty = tidx() >> 5;
  __syncthreads();
#pragma unroll
  for (int i = 0; i < 4; i++) { int k = ty + i * 8; sm[k * 33 + tx] = W[(size_t)(kt * 32 + k) * N + nt * 32 + tx]; }
  __syncthreads();
#pragma unroll
  for (int i = 0; i < 4; i++) { int n = ty + i * 8; Wt[(size_t)(nt * 32 + n) * ldt + kt * 32 + tx] = f2bf(sm[tx * 33 + n]); }
}
DEV void convert_chunk(const float* __restrict__ src, bf16_t* __restrict__ dst, int chunk) {
  size_t o = (size_t)chunk * 2048 + tidx() * 8;
  float4 a = *(const float4*)(src + o), b = *(const float4*)(src + o + 4);
  uint4 r; r.x = pack2(a.x, a.y); r.y = pack2(a.z, a.w); r.z = pack2(b.x, b.y); r.w = pack2(b.z, b.w);
  *(uint4*)(dst + o) = r;
}

#define NT_WIN   1440
#define NT_WUQ   192
#define NT_WUKV  128
#define NT_WOUT  1024
#define NT_HGIN  5120
#define NT_HGOUT 1024
#define NT_WPQ   4096
#define P0_TR (NT_WIN + NT_WUQ + NT_WUKV + NT_WOUT + NT_HGIN + NT_HGOUT + NT_WPQ)
#define P0_CV_SUBK 256
#define P0_CV_U 2048
#define P0_CV_V 2048
#define P0_ZP 51
#define P0_MOD 384
#define P0_ROPE 512
#define P0_ITEMS (P0_TR + P0_CV_SUBK + P0_CV_U + P0_CV_V + P0_ZP + P0_MOD + P0_ROPE)

DEV void phase_prep(const Params& p, char* smem) {
  for (int item = blockIdx.x; item < P0_ITEMS; item += gridDim.x) {
    int it = item;
    if (it < P0_TR) {
      if (it < NT_WIN) { transpose_tile(p.in[I_WIN], 1024, 1440, WSP(bf16_t, S_WIN0), LDH, it, smem); continue; }
      it -= NT_WIN;
      if (it < NT_WUQ) { transpose_tile(p.in[I_WUQ], 256, 768, WSP(bf16_t, S_WUQ), 256, it, smem); continue; }
      it -= NT_WUQ;
      if (it < NT_WUKV) { transpose_tile(p.in[I_WUKV], 128, 1024, WSP(bf16_t, S_WUKV), 128, it, smem); continue; }
      it -= NT_WUKV;
      if (it < NT_WOUT) { transpose_tile(p.in[I_WOUT], 1024, 1024, WSP(bf16_t, S_WOUT0), LDH, it, smem); continue; }
      it -= NT_WOUT;
      if (it < NT_HGIN) { transpose_tile(p.in[I_HGWIN], 1024, 5120, WSP(bf16_t, S_WHGIN), LDH, it, smem); continue; }
      it -= NT_HGIN;
      if (it < NT_HGOUT) { transpose_tile(p.in[I_HGWOUT], 1024, 1024, WSP(bf16_t, S_WHGOUT), LDH, it, smem); continue; }
      it -= NT_HGOUT;
      int l = it >> 11; it &= 2047;
      transpose_tile(p.in[I_PWQ] + (size_t)l * 1024 * 2048, 1024, 2048, WSP(bf16_t, S_WPQ) + (size_t)l * 2048 * LDH, LDH, it, smem);
      continue;
    }
    it -= P0_TR;
    if (it < P0_CV_SUBK) { convert_chunk(p.in[I_PSK], WSP(bf16_t, S_SUBK), it); continue; }
    it -= P0_CV_SUBK;
    if (it < P0_CV_U + P0_CV_V) {
      const int isv = it >= P0_CV_U; const int r16 = isv ? it - P0_CV_U : it;
      const int lane = tidx() & 63;
      const int rowb = r16 * 16 + (tidx() >> 6) * 4;
      const float* src = (isv ? p.in[I_PV] : p.in[I_PU]) + (size_t)rowb * 1024 + lane * 16;
      float4 v[4][4];
#pragma unroll
      for (int r = 0; r < 4; r++)
#pragma unroll
        for (int q = 0; q < 4; q++) v[r][q] = *(const float4*)(src + (size_t)r * 1024 + q * 4);
#pragma unroll
      for (int r = 0; r < 4; r++) {
        float mx = 0.f;
#pragma unroll
        for (int q = 0; q < 4; q++) mx = fmaxf(mx, fmaxf(fmaxf(fabsf(v[r][q].x), fabsf(v[r][q].y)), fmaxf(fabsf(v[r][q].z), fabsf(v[r][q].w))));
#pragma unroll
        for (int o = 32; o > 0; o >>= 1) mx = fmaxf(mx, __shfl_xor(mx, o));
        mx = fmaxf(mx, 1e-30f);
        const float sc = exp2f(floorf(log2f(384.f / mx)));
        unsigned ow[4];
#pragma unroll
        for (int q = 0; q < 4; q++) {
          int t = __builtin_amdgcn_cvt_pk_fp8_f32(v[r][q].x * sc, v[r][q].y * sc, 0, false);
          t = __builtin_amdgcn_cvt_pk_fp8_f32(v[r][q].z * sc, v[r][q].w * sc, t, true);
          ow[q] = (unsigned)t;
        }
        const int row = rowb + r; const int l = row >> 14, e = row & 16383;
        unsigned char* dst = isv ? (l ? WSP(unsigned char, OFF_V1) : WSP(unsigned char, OFF_V0)) : (l ? WSP(unsigned char, OFF_U1) : WSP(unsigned char, OFF_U0));
        *(uint4*)(dst + (size_t)e * 1024 + lane * 16) = make_uint4(ow[0], ow[1], ow[2], ow[3]);
        if (lane == 0) WSP(float, S_UVSC)[(l * 2 + isv) * 16384 + e] = 1.f / sc;
      }
      continue;
    }
    it -= P0_CV_U;
    it -= P0_CV_V;
    if (it < P0_ZP) {
      bf16_t* dst = WSP(bf16_t, S_WIN0) + (size_t)1440 * LDH + (size_t)it * 2048 + tidx() * 8;
      *(uint4*)dst = make_uint4(0u, 0u, 0u, 0u);
      continue;
    }
    it -= P0_ZP;
    if (it < P0_MOD) {
      const int l = it / 192, nb = it - l * 192;
      const int col = tidx() & 31, kg = tidx() >> 5;
      const int n = nb * 32 + col;
      const float* W = p.in[I_ADAW] + (size_t)l * 1024 * 6144;
      float* sv = (float*)smem;
      float* red = sv + 3072;
      __syncthreads();
      for (int i = tidx(); i < 3072; i += 256) {
        const int r = i >> 10, k = i & 1023;
        const float c = (r < 2) ? p.in[I_C][r * 1024 + k] : p.in[I_CCTX][k];
        sv[i] = c * sigm(c);
      }
      __syncthreads();
      float a0 = 0.f, a1 = 0.f, a2 = 0.f;
      const float* wp = W + (size_t)(kg * 128) * 6144 + n;
#pragma unroll 1
      for (int kb = 0; kb < 128; kb += 32) {
        float wv[32];
#pragma unroll
        for (int u = 0; u < 32; u++) wv[u] = wp[(size_t)(kb + u) * 6144];
#pragma unroll
        for (int u = 0; u < 32; u++) {
          const int k = kg * 128 + kb + u;
          a0 += sv[k] * wv[u]; a1 += sv[1024 + k] * wv[u]; a2 += sv[2048 + k] * wv[u];
        }
      }
      red[(kg * 32 + col) * 3 + 0] = a0; red[(kg * 32 + col) * 3 + 1] = a1; red[(kg * 32 + col) * 3 + 2] = a2;
      __syncthreads();
      if (tidx() < 96) {
        int r = tidx() >> 5, cc = tidx() & 31;
        float sum = 0.f;
        for (int g = 0; g < 8; g++) sum += red[(g * 32 + cc) * 3 + r];
        int nn = nb * 32 + cc;
        WSP(float, S_MOD)[(size_t)(l * 3 + r) * 6144 + nn] = sum + p.in[I_ADAB][l * 6144 + nn];
      }
      continue;
    }
    it -= P0_MOD;
    {
      int idx = it * 256 + tidx();
      int t = idx >> 4, i = idx & 15;
      int f = i & 7;
      float pos = (i < 8) ? (float)(t >> 6) : (float)(t & 63);
      float inv = powf(10000.f, -(float)(2 * f) / 16.f);
      float ang = pos * inv;
      WSP(float, S_ROPEC)[idx] = cosf(ang);
      WSP(float, S_ROPES)[idx] = sinf(ang);
    }
  }
}

DEV void phase_norm(const Params& p, int layer, int which, int M, bool from_inputs) {
  const float* g = p.in[which ? I_N2G : I_N1G] + layer * 1024;
  const float* mod = WSP(float, S_MOD) + (size_t)layer * 3 * 6144;
  const int shift_c = which ? 3 : 0, scale_c = which ? 4 : 1;
  const float* X = WSP(float, OFF_X);
  bf16_t* H = WSP(bf16_t, OFF_H);
  const int wave = tidx() >> 6, lane = tidx() & 63;
  for (int row = blockIdx.x * 4 + wave; row < M; row += gridDim.x * 4) {
    const float* src; int mr;
    if (row < MM) { src = (from_inputs ? p.in[I_X] : X) + (size_t)row * 1024; mr = row >> 13; }
    else { src = from_inputs ? (p.in[I_CTX] + (size_t)(row - MM) * 1024) : (X + (size_t)row * 1024); mr = 2; }
    float4 v[4]; float ss = 0.f;
#pragma unroll
    for (int i = 0; i < 4; i++) {
      v[i] = ((const float4*)src)[lane + i * 64];
      ss += v[i].x * v[i].x + v[i].y * v[i].y + v[i].z * v[i].z + v[i].w * v[i].w;
    }
    ss = wave_sum(ss);
    const float rinv = rsqrtf(ss * (1.f / 1024.f) + 1e-6f);
    const float* msh = mod + (size_t)mr * 6144 + shift_c * 1024;
    const float* msc = mod + (size_t)mr * 6144 + scale_c * 1024;
#pragma unroll
    for (int i = 0; i < 4; i++) {
      int c4 = lane + i * 64;
      float4 g4 = ((const float4*)g)[c4], sh = ((const float4*)msh)[c4], sc = ((const float4*)msc)[c4];
      float o0 = v[i].x * rinv * g4.x * (1.f + sc.x) + sh.x;
      float o1 = v[i].y * rinv * g4.y * (1.f + sc.y) + sh.y;
      float o2 = v[i].z * rinv * g4.z * (1.f + sc.z) + sh.z;
      float o3 = v[i].w * rinv * g4.w * (1.f + sc.w) + sh.w;
      uint2 r; r.x = pack2(o0, o1); r.y = pack2(o2, o3);
      *(uint2*)(H + (size_t)row * LDH + c4 * 4) = r;
    }
  }
}

struct EpiP0 {
  bf16_t* P0;
  DEV void operator()(int m, int n, f32x4 v) {
    if (n < 1440) { uint2 r; r.x = pack2(v[0], v[1]); r.y = pack2(v[2], v[3]); *(uint2*)(P0 + (size_t)m * 1536 + n) = r; }
  }
};
DEV void phase_gemm_win(const Params& p, char* smem) {
  EpiP0 epi{WSP(bf16_t, R_P0)};
  const int NTL = 12, items = (MT / 128) * NTL;
  for (int item = blockIdx.x; item < items; item += gridDim.x) {
    int mt = item / NTL, nt = item - mt * NTL;
    gemm_tile(WSP(bf16_t, OFF_H), LDH, WSP(bf16_t, S_WIN0), LDH, 1024, mt * 128, nt * 128, epi, smem);
  }
}

DEV void phase_post1(const Params& p) {
  const bf16_t* P0 = WSP(bf16_t, R_P0);
  bf16_t* QN = WSP(bf16_t, R_QN); bf16_t* KVN = WSP(bf16_t, R_KVN); bf16_t* YG = WSP(bf16_t, R_YG);
  bf16_t* Kb = WSP(bf16_t, R_K);
  const float* rc = WSP(float, S_ROPEC); const float* rs = WSP(float, S_ROPES);
  const float* qg = p.in[I_QG]; const float* kvg = p.in[I_KVG];
  const int wave = tidx() >> 6, lane = tidx() & 63;
  for (int row = blockIdx.x * 4 + wave; row < MT; row += gridDim.x * 4) {
    const bf16_t* pr = P0 + (size_t)row * 1536;
    {
      uint2 u = *(const uint2*)(pr + lane * 4);
      float a0 = bflo(u.x), a1 = bfhi(u.x), a2 = bflo(u.y), a3 = bfhi(u.y);
      float ss = wave_sum(a0 * a0 + a1 * a1 + a2 * a2 + a3 * a3);
      float rinv = rsqrtf(ss * (1.f / 256.f) + 1e-6f);
      float4 g4 = ((const float4*)qg)[lane];
      uint2 r; r.x = pack2(a0 * rinv * g4.x, a1 * rinv * g4.y); r.y = pack2(a2 * rinv * g4.z, a3 * rinv * g4.w);
      *(uint2*)(QN + (size_t)row * 256 + lane * 4) = r;
    }
    {
      unsigned u = *(const unsigned*)(pr + 256 + lane * 2);
      float a0 = bflo(u), a1 = bfhi(u);
      float ss = wave_sum(a0 * a0 + a1 * a1);
      float rinv = rsqrtf(ss * (1.f / 128.f) + 1e-6f);
      float2 g2 = ((const float2*)kvg)[lane];
      *(unsigned*)(KVN + (size_t)row * 128 + lane * 2) = pack2(a0 * rinv * g2.x, a1 * rinv * g2.y);
    }
    if (lane < 16) {
      unsigned u = *(const unsigned*)(pr + 384 + lane * 2);
      float x0 = bflo(u), x1 = bfhi(u);
      int b, pos;
      if (row < MM) {
        b = row >> 13; int t = row & 8191; pos = 256 + t;
        float c = rc[t * 16 + lane], s = rs[t * 16 + lane];
        float y0 = x0 * c - x1 * s, y1 = x0 * s + x1 * c; x0 = y0; x1 = y1;
      } else { int rr = row - MM; b = rr >> 8; pos = rr & 255; }
      unsigned o = pack2(x0, x1);
#pragma unroll
      for (int h = 0; h < 8; h++) *(unsigned*)(Kb + ((size_t)(b * 8 + h) * 8448 + pos) * 96 + 64 + lane * 2) = o;
    }
    {
      uint4 ua = *(const uint4*)(pr + 416 + lane * 8);
      uint4 ug = *(const uint4*)(pr + 416 + 512 + lane * 8);
      uint4 r;
      r.x = pack2(bflo(ua.x) * sigm(bflo(ug.x)), bfhi(ua.x) * sigm(bfhi(ug.x)));
      r.y = pack2(bflo(ua.y) * sigm(bflo(ug.y)), bfhi(ua.y) * sigm(bfhi(ug.y)));
      r.z = pack2(bflo(ua.z) * sigm(bflo(ug.z)), bfhi(ua.z) * sigm(bfhi(ug.z)));
      r.w = pack2(bflo(ua.w) * sigm(bflo(ug.w)), bfhi(ua.w) * sigm(bfhi(ug.w)));
      *(uint4*)(YG + (size_t)row * 512 + lane * 8) = r;
    }
  }
}

#define QSCALE 0.14724738f
struct EpiQ {
  bf16_t* Q; bf16_t* Qc; const float* rc; const float* rs;
  DEV void operator()(int m, int n, f32x4 v) {
    int head = n / 96, d = n - head * 96;
    if (m < MM) {
      int b = m >> 13, t = m & 8191;
      if (d >= 64) {
        int i0 = (d - 64) >> 1;
        float c0 = rc[t * 16 + i0], s0 = rs[t * 16 + i0], c1 = rc[t * 16 + i0 + 1], s1 = rs[t * 16 + i0 + 1];
        float y0 = v[0] * c0 - v[1] * s0, y1 = v[0] * s0 + v[1] * c0;
        float y2 = v[2] * c1 - v[3] * s1, y3 = v[2] * s1 + v[3] * c1;
        v[0] = y0; v[1] = y1; v[2] = y2; v[3] = y3;
      }
      uint2 r; r.x = pack2(v[0] * QSCALE, v[1] * QSCALE); r.y = pack2(v[2] * QSCALE, v[3] * QSCALE);
      *(uint2*)(Q + ((size_t)(b * 8 + head) * 8192 + t) * 96 + d) = r;
    } else {
      int rr = m - MM; int b = rr >> 8, t = rr & 255;
      uint2 r; r.x = pack2(v[0] * QSCALE, v[1] * QSCALE); r.y = pack2(v[2] * QSCALE, v[3] * QSCALE);
      *(uint2*)(Qc + ((size_t)(b * 8 + head) * 256 + t) * 96 + d) = r;
    }
  }
};
struct EpiKV {
  bf16_t* K; bf16_t* Vt;
  DEV void operator()(int m, int n, f32x4 v) {
    int head = n >> 7, d = n & 127;
    int b, pos;
    if (m < MM) { b = m >> 13; pos = 256 + (m & 8191); } else { int rr = m - MM; b = rr >> 8; pos = rr & 255; }
    if (d < 64) {
      uint2 r; r.x = pack2(v[0], v[1]); r.y = pack2(v[2], v[3]);
      *(uint2*)(K + ((size_t)(b * 8 + head) * 8448 + pos) * 96 + d) = r;
    } else {
      bf16_t* vp = Vt + ((size_t)(b * 8 + head) * 64 + (d - 64)) * 8448 + pos;
      vp[0] = f2bf(v[0]); vp[8448] = f2bf(v[1]); vp[2 * 8448] = f2bf(v[2]); vp[3 * 8448] = f2bf(v[3]);
    }
  }
};

DEV void conv_tile(const Params& p, int tile, char* smem) {
  const bf16_t* YG = WSP(bf16_t, R_YG);
  bf16_t* MIX = WSP(bf16_t, R_MIX);
  const int r0 = tile * 8;
  int seq_start, seq_len;
  if (r0 < MM) { seq_start = (r0 >> 13) << 13; seq_len = 8192; }
  else { int rr = r0 - MM; seq_start = MM + ((rr >> 8) << 8); seq_len = 256; }
  const int t0 = r0 - seq_start;
  const int tid = tidx();
  const int c = tid * 2;
  const int lane = tid & 63, w = tid >> 6;
  bf16_t* stg = (bf16_t*)smem;
  float* ybuf = (float*)(smem + 38 * 1024);
  float* red = ybuf + 8 * 512;
  __syncthreads();
  for (int id = tid; id < 38 * 64; id += 256) {
    const int row = id >> 6, cc = id & 63;
    const int t = t0 - 15 + row;
    uint4 v = make_uint4(0u, 0u, 0u, 0u);
    if (t >= 0 && t < seq_len) v = *(const uint4*)(YG + (size_t)(seq_start + t) * 512 + cc * 8);
    *(uint4*)(stg + row * 512 + cc * 8) = v;
  }
  float w0[31], w1[31];
  const float* cw = p.in[I_CONVW];
#pragma unroll
  for (int i = 0; i < 31; i++) { float2 t = *(const float2*)(cw + i * 512 + c); w0[i] = t.x; w1[i] = t.y; }
  const float2 bb = *(const float2*)(p.in[I_CONVB] + c);
  __syncthreads();
#pragma unroll 1
  for (int i = 0; i < 8; i++) {
    float a0 = bb.x, a1 = bb.y;
#pragma unroll
    for (int wi = 0; wi < 31; wi++) {
      unsigned u = *(const unsigned*)(stg + (i + wi) * 512 + c);
      a0 += bflo(u) * w0[wi]; a1 += bfhi(u) * w1[wi];
    }
    *(float2*)(ybuf + i * 512 + c) = make_float2(a0, a1);
    float s1 = wave_sum(a0 + a1);
    float s2 = wave_sum(a0 * a0 + a1 * a1);
    if (lane == 0) { red[(i * 4 + w) * 2] = s1; red[(i * 4 + w) * 2 + 1] = s2; }
  }
  __syncthreads();
  const float2 lg = *(const float2*)(p.in[I_LNG] + c), lb = *(const float2*)(p.in[I_LNB] + c);
#pragma unroll
  for (int i = 0; i < 8; i++) {
    float S1 = red[i * 8] + red[i * 8 + 2] + red[i * 8 + 4] + red[i * 8 + 6];
    float S2 = red[i * 8 + 1] + red[i * 8 + 3] + red[i * 8 + 5] + red[i * 8 + 7];
    float mean = S1 * (1.f / 512.f);
    float var = fmaxf(S2 * (1.f / 512.f) - mean * mean, 0.f);
    float rinv = rsqrtf(var + 1e-6f);
    float2 y = *(const float2*)(ybuf + i * 512 + c);
    float y0 = (y.x - mean) * rinv * lg.x + lb.x;
    float y1 = (y.y - mean) * rinv * lg.y + lb.y;
    y0 = y0 * sigm(y0); y1 = y1 * sigm(y1);
    *(unsigned*)(MIX + (size_t)(r0 + i) * LDH + 512 + c) = pack2(y0, y1);
  }
}

#define NI_GQ (132 * 6)
#define NI_GKV (132 * 8)
#define NI_CONV (MT / 8)
DEV void phase_qkv_conv(const Params& p, char* smem) {
  EpiQ eq{WSP(bf16_t, R_Q), WSP(bf16_t, R_QC), WSP(float, S_ROPEC), WSP(float, S_ROPES)};
  EpiKV ekv{WSP(bf16_t, R_K), WSP(bf16_t, R_VT)};
  for (int item = blockIdx.x; item < NI_GQ + NI_GKV + NI_CONV; item += gridDim.x) {
    int it = item;
    if (it < NI_GQ) { int mt = it / 6, nt = it - mt * 6; gemm_tile(WSP(bf16_t, R_QN), 256, WSP(bf16_t, S_WUQ), 256, 256, mt * 128, nt * 128, eq, smem); continue; }
    it -= NI_GQ;
    if (it < NI_GKV) { int mt = it >> 3, nt = it & 7; gemm_tile(WSP(bf16_t, R_KVN), 128, WSP(bf16_t, S_WUKV), 128, 128, mt * 128, nt * 128, ekv, smem); continue; }
    it -= NI_GKV;
    conv_tile(p, it, smem);
  }
}

typedef __attribute__((ext_vector_type(16))) float f32x16;
DEV f32x16 mfma32(bf16x8 a, bf16x8 b, f32x16 c) { return __builtin_amdgcn_mfma_f32_32x32x16_bf16(a, b, c, 0, 0, 0); }
#define ASTR 104
#define VSTR 44
DEV void attn_item(const Params& p, int item, char* smem) {
  const int tid = tidx(), lane = tid & 63, w = tid >> 6, c31 = lane & 31, hf = lane >> 5;
  const bf16_t* Qb; int nkeys; size_t out_row0; int bh;
  if (item < 512) {
    bh = item >> 5; int q0 = (item & 31) * 256;
    Qb = WSP(bf16_t, R_Q) + ((size_t)bh * 8192 + q0) * 96; nkeys = 8448; out_row0 = (size_t)(bh >> 3) * 8192 + q0;
  } else {
    bh = item - 512;
    Qb = WSP(bf16_t, R_QC) + ((size_t)bh * 256) * 96; nkeys = 256; out_row0 = (size_t)MM + (bh >> 3) * 256;
  }
  const int h = bh & 7;
  const bf16_t* Kb = WSP(bf16_t, R_K) + (size_t)bh * 8448 * 96;
  const bf16_t* Vb = WSP(bf16_t, R_VT) + (size_t)bh * 64 * 8448;
  bf16_t* Ks = (bf16_t*)smem;
  bf16_t* Vs = Ks + 2 * 32 * ASTR;
  bf16x8 qf[2][6];
#pragma unroll
  for (int jt = 0; jt < 2; jt++)
#pragma unroll
    for (int ks = 0; ks < 6; ks++) qf[jt][ks] = *(const bf16x8*)(Qb + (size_t)(w * 64 + jt * 32 + c31) * 96 + ks * 16 + hf * 8);
  f32x16 o[2][2];
#pragma unroll
  for (int dt = 0; dt < 2; dt++)
#pragma unroll
    for (int jt = 0; jt < 2; jt++)
#pragma unroll
      for (int r = 0; r < 16; r++) o[dt][jt][r] = 0.f;
  float mrun[2] = {-1e30f, -1e30f}, lrun[2] = {0.f, 0.f};
  u32x4 rk0, rk1, rv0;
  const int k0row = tid / 12, k0cc = tid - k0row * 12;
  const int k1id = 256 + (tid & 127), k1row = k1id / 12, k1cc = k1id - k1row * 12;
  const bool has_k1 = tid < 128;
  const int vrow = tid >> 2, vcc = tid & 3;
  const int ntile = nkeys >> 5;
  __syncthreads();
  rk0 = *(const u32x4*)(Kb + (size_t)k0row * 96 + k0cc * 8);
  rk1 = *(const u32x4*)(Kb + (size_t)k1row * 96 + k1cc * 8);
  rv0 = *(const u32x4*)(Vb + (size_t)vrow * 8448 + vcc * 8);
  *(u32x4*)(Ks + k0row * ASTR + k0cc * 8) = rk0;
  if (has_k1) *(u32x4*)(Ks + k1row * ASTR + k1cc * 8) = rk1;
  *(uint2*)(Vs + vrow * VSTR + vcc * 8) = make_uint2(rv0[0], rv0[1]);
  *(uint2*)(Vs + vrow * VSTR + vcc * 8 + 4) = make_uint2(rv0[2], rv0[3]);
  __syncthreads();
  if (ntile > 1) {
    rk0 = *(const u32x4*)(Kb + (size_t)(32 + k0row) * 96 + k0cc * 8);
    rk1 = *(const u32x4*)(Kb + (size_t)(32 + k1row) * 96 + k1cc * 8);
    rv0 = *(const u32x4*)(Vb + (size_t)vrow * 8448 + 32 + vcc * 8);
  }
  for (int kt = 0; kt < ntile; kt++) {
    const bf16_t* Kc = Ks + (kt & 1) * (32 * ASTR);
    const bf16_t* Vc = Vs + (kt & 1) * (64 * VSTR);
    f32x16 s[2];
#pragma unroll
    for (int jt = 0; jt < 2; jt++) {
#pragma unroll
      for (int r = 0; r < 16; r++) s[jt][r] = 0.f;
#pragma unroll
      for (int ks = 0; ks < 6; ks++) {
        bf16x8 kf = *(const bf16x8*)(Kc + c31 * ASTR + ks * 16 + hf * 8);
        s[jt] = mfma32(kf, qf[jt][ks], s[jt]);
      }
    }
#pragma unroll
    for (int jt = 0; jt < 2; jt++) {
      float m0 = fmaxf(fmaxf(s[jt][0], s[jt][1]), fmaxf(s[jt][2], s[jt][3]));
      float m1 = fmaxf(fmaxf(s[jt][4], s[jt][5]), fmaxf(s[jt][6], s[jt][7]));
      float m2 = fmaxf(fmaxf(s[jt][8], s[jt][9]), fmaxf(s[jt][10], s[jt][11]));
      float m3 = fmaxf(fmaxf(s[jt][12], s[jt][13]), fmaxf(s[jt][14], s[jt][15]));
      const float mx = fmaxf(fmaxf(m0, m1), fmaxf(m2, m3));
      if (__any(mx > mrun[jt])) {
        const float mxa = fmaxf(mx, __shfl_xor(mx, 32));
        const float mnew = fmaxf(mrun[jt], mxa);
        const float alpha = __builtin_amdgcn_exp2f(mrun[jt] - mnew);
        mrun[jt] = mnew;
        lrun[jt] *= alpha;
#pragma unroll
        for (int dt = 0; dt < 2; dt++)
#pragma unroll
          for (int r = 0; r < 16; r++) o[dt][jt][r] *= alpha;
      }
      const float mcur = mrun[jt];
      float pv[16];
#pragma unroll
      for (int r = 0; r < 16; r++) pv[r] = __builtin_amdgcn_exp2f(s[jt][r] - mcur);
      lrun[jt] += (((pv[0] + pv[1]) + (pv[2] + pv[3])) + ((pv[4] + pv[5]) + (pv[6] + pv[7]))) +
                  (((pv[8] + pv[9]) + (pv[10] + pv[11])) + ((pv[12] + pv[13]) + (pv[14] + pv[15])));
      bf16x8 pf[2];
#pragma unroll
      for (int ss = 0; ss < 2; ss++) {
        uint4 u; u.x = pack2(pv[8 * ss + 0], pv[8 * ss + 1]); u.y = pack2(pv[8 * ss + 2], pv[8 * ss + 3]);
        u.z = pack2(pv[8 * ss + 4], pv[8 * ss + 5]); u.w = pack2(pv[8 * ss + 6], pv[8 * ss + 7]);
        pf[ss] = __builtin_bit_cast(bf16x8, u);
      }
#pragma unroll
      for (int dt = 0; dt < 2; dt++)
#pragma unroll
        for (int ss = 0; ss < 2; ss++) {
          uint2 lo = *(const uint2*)(Vc + (dt * 32 + c31) * VSTR + 16 * ss + 4 * hf);
          uint2 hi = *(const uint2*)(Vc + (dt * 32 + c31) * VSTR + 16 * ss + 8 + 4 * hf);
          uint4 u; u.x = lo.x; u.y = lo.y; u.z = hi.x; u.w = hi.y;
          o[dt][jt] = mfma32(__builtin_bit_cast(bf16x8, u), pf[ss], o[dt][jt]);
        }
    }
    if (kt + 1 < ntile) {
      bf16_t* Kn = Ks + ((kt + 1) & 1) * (32 * ASTR);
      bf16_t* Vn = Vs + ((kt + 1) & 1) * (64 * VSTR);
      *(u32x4*)(Kn + k0row * ASTR + k0cc * 8) = rk0;
      if (has_k1) *(u32x4*)(Kn + k1row * ASTR + k1cc * 8) = rk1;
      *(uint2*)(Vn + vrow * VSTR + vcc * 8) = make_uint2(rv0[0], rv0[1]);
      *(uint2*)(Vn + vrow * VSTR + vcc * 8 + 4) = make_uint2(rv0[2], rv0[3]);
      __syncthreads();
      if (kt + 2 < ntile) {
        rk0 = *(const u32x4*)(Kb + (size_t)((kt + 2) * 32 + k0row) * 96 + k0cc * 8);
        rk1 = *(const u32x4*)(Kb + (size_t)((kt + 2) * 32 + k1row) * 96 + k1cc * 8);
        rv0 = *(const u32x4*)(Vb + (size_t)vrow * 8448 + (kt + 2) * 32 + vcc * 8);
      }
    }
  }
  bf16_t* MIX = WSP(bf16_t, R_MIX);
#pragma unroll
  for (int jt = 0; jt < 2; jt++) {
    float l = lrun[jt];
    l += __shfl_xor(l, 32);
    const float inv = 1.f / l;
    const size_t row = out_row0 + w * 64 + jt * 32 + c31;
#pragma unroll
    for (int dt = 0; dt < 2; dt++)
#pragma unroll
      for (int g4 = 0; g4 < 4; g4++) {
        uint2 r; r.x = pack2(o[dt][jt][4 * g4 + 0] * inv, o[dt][jt][4 * g4 + 1] * inv); r.y = pack2(o[dt][jt][4 * g4 + 2] * inv, o[dt][jt][4 * g4 + 3] * inv);
        *(uint2*)(MIX + row * LDH + h * 64 + dt * 32 + 8 * g4 + 4 * hf) = r;
      }
  }
}
DEV void phase_attn(const Params& p, char* smem) {
  for (int item = blockIdx.x; item < 512 + 16; item += gridDim.x) attn_item(p, item, smem);
}

struct EpiRes {
  const float* xin_main; const float* xin_ctx; float* X; const float* mod;
  DEV void operator()(int m, int n, f32x4 v) {
    const float* src; int mr;
    if (m < MM) { src = xin_main + (size_t)m * 1024 + n; mr = m >> 13; } else { src = xin_ctx + (size_t)(m - MM) * 1024 + n; mr = 2; }
    float4 xo = *(const float4*)src;
    float4 g = *(const float4*)(mod + (size_t)mr * 6144 + 2048 + n);
    float4 r; r.x = xo.x + g.x * v[0]; r.y = xo.y + g.y * v[1]; r.z = xo.z + g.z * v[2]; r.w = xo.w + g.w * v[3];
    *(float4*)(X + (size_t)m * 1024 + n) = r;
  }
};
DEV void phase_gemm_out(const Params& p, int layer, char* smem) {
  float* X = WSP(float, OFF_X);
  EpiRes epi;
  epi.X = X; epi.mod = WSP(float, S_MOD) + (size_t)layer * 3 * 6144;
  const bf16_t* A; const bf16_t* Bt; int M;
  if (layer == 0) { epi.xin_main = p.in[I_X]; epi.xin_ctx = p.in[I_CTX]; A = WSP(bf16_t, R_MIX); Bt = WSP(bf16_t, S_WOUT0); M = MT; }
  else { epi.xin_main = X; epi.xin_ctx = X + (size_t)MM * 1024; A = WSP(bf16_t, OFF_H); Bt = WSP(bf16_t, S_WHGOUT); M = MM; }
  const int items = xcd_tile_items(M / 128, 8);
  for (int item = blockIdx.x; item < items; item += gridDim.x) {
    int mt, nt;
    if (!xcd_tile(item, M / 128, 8, mt, nt)) continue;
    gemm_tile(A, LDH, Bt, LDH, 1024, mt * 128, nt * 128, epi, smem);
  }
}

struct EpiBf {
  bf16_t* C; int ldc;
  DEV void operator()(int m, int n, f32x4 v) {
    uint2 r; r.x = pack2(v[0], v[1]); r.y = pack2(v[2], v[3]);
    *(uint2*)(C + (size_t)m * ldc + n) = r;
  }
};
DEV void phase_gemm_pq(const Params& p, int layer, int M, char* smem) {
  EpiBf epi{layer ? WSP(bf16_t, L1_PQ) : WSP(bf16_t, R_PQ), 2048};
  const bf16_t* Bt = WSP(bf16_t, S_WPQ) + (size_t)layer * 2048 * LDH;
  const int items = xcd_tile_items(M / 128, 16);
  for (int item = blockIdx.x; item < items; item += gridDim.x) {
    int mt, nt;
    if (!xcd_tile(item, M / 128, 16, mt, nt)) continue;
    gemm_tile(WSP(bf16_t, OFF_H), LDH, Bt, LDH, 1024, mt * 128, nt * 128, epi, smem);
  }
}

DEV void ce(float& a, float& b) { float hi = fmaxf(a, b), lo = fminf(a, b); a = hi; b = lo; }
DEV void bitonic16(float (&l)[16]) {
#pragma unroll
  for (int s = 8; s > 0; s >>= 1)
#pragma unroll
    for (int i = 0; i < 16; i++)
      if (!(i & s)) ce(l[i], l[i + s]);
}
DEV void sort16_desc(float (&a)[16]) {
#pragma unroll
  for (int k = 2; k <= 16; k <<= 1)
#pragma unroll
    for (int j = k >> 1; j > 0; j >>= 1)
#pragma unroll
      for (int i = 0; i < 16; i++) {
        const int p = i ^ j;
        if (p > i) { if ((i & k) == 0) ce(a[i], a[p]); else ce(a[p], a[i]); }
      }
}
DEV void merge_xor(float (&l)[16], int mask) {
  float t[16];
#pragma unroll
  for (int i = 0; i < 16; i++) t[i] = __shfl_xor(l[15 - i], mask);
#pragma unroll
  for (int i = 0; i < 16; i++) l[i] = fmaxf(l[i], t[i]);
  bitonic16(l);
}
DEV void peer_top16(const bf16_t* __restrict__ pq, const bf16_t* sk  , float (&l)[16]) {
  const int lane = tidx() & 63, l15 = lane & 15, quad = lane >> 4;
  f32x4 acc[8];
#pragma unroll
  for (int nt = 0; nt < 8; nt++) acc[nt] = (f32x4){0.f, 0.f, 0.f, 0.f};
#pragma unroll 1
  for (int ks = 0; ks < 4; ks++) {
    const bf16x8 bqk = *(const bf16x8*)(pq + ks * 32 + quad * 8);
#pragma unroll
    for (int nt = 0; nt < 8; nt++) {
      bf16x8 ak = *(const bf16x8*)(sk + (nt * 16 + l15) * 144 + ks * 32 + quad * 8);
      acc[nt] = mfma16(ak, bqk, acc[nt]);
    }
  }
  float hi[16];
#pragma unroll
  for (int nt = 0; nt < 4; nt++)
#pragma unroll
    for (int r = 0; r < 4; r++) {
      l[nt * 4 + r] = __uint_as_float((__float_as_uint(acc[nt][r]) & ~127u) | (unsigned)(nt * 16 + quad * 4 + r));
      hi[nt * 4 + r] = __uint_as_float((__float_as_uint(acc[nt + 4][r]) & ~127u) | (unsigned)((nt + 4) * 16 + quad * 4 + r));
    }
  sort16_desc(l);
  sort16_desc(hi);
#pragma unroll
  for (int i = 0; i < 16; i++) l[i] = fmaxf(l[i], hi[15 - i]);
  bitonic16(l);
  merge_xor(l, 16);
  merge_xor(l, 32);
}
DEV void phase_peer_score(const Params& p, int layer, int M, char* smem) {
  const bf16_t* PQ = layer ? WSP(bf16_t, L1_PQ) : WSP(bf16_t, R_PQ);
  int* EIDX = layer ? WSP(int, L1_EIDX) : WSP(int, R_EIDX);
  float* GATE = layer ? WSP(float, L1_GATE) : WSP(float, R_GATE);
  const bf16_t* SK = WSP(bf16_t, S_SUBK) + (size_t)layer * 16 * 128 * 128;
  const float* USC = WSP(float, S_UVSC) + (size_t)(layer * 2) * 16384;
  const int tid = tidx(), lane = tid & 63, w = tid >> 6, l15 = lane & 15, quad = lane >> 4;
  const int items = (M / 64) * 8;
  bf16_t* SKs = (bf16_t*)smem;
  int hcur = -1;
  for (int item = blockIdx.x; item < items; item += gridDim.x) {
    const int mtile = item >> 3, h = item & 7;
    if (h != hcur) {
      hcur = h;
      __syncthreads();
#pragma unroll
      for (int i = 0; i < 16; i++) {
        int id = tid + i * 256; int row = id >> 4, cc = id & 15;
        *(uint4*)(SKs + row * 144 + cc * 8) = *(const uint4*)(SK + ((size_t)h * 256 + row) * 128 + cc * 8);
      }
      __syncthreads();
    }
    const int m = mtile * 64 + w * 16 + l15;
    float L0[16], L1[16];
    peer_top16(PQ + (size_t)m * 2048 + h * 256, SKs, L0);
    peer_top16(PQ + (size_t)m * 2048 + h * 256 + 128, SKs + 128 * 144, L1);
    float R[16];
#pragma unroll
    for (int i = 0; i < 16; i++) R[i] = -3.0e38f;
#pragma unroll
    for (int i = 0; i < 16; i++)
#pragma unroll
      for (int j = 0; j < 16; j++)
        if ((i + 1) * (j + 1) <= 16) {
          float v = L0[i] + L1[j];
          v = __uint_as_float((__float_as_uint(v) & ~255u) | (unsigned)(i * 16 + j));
#pragma unroll
          for (int t = 0; t < 16; t++)
            if (t >= (i + 1) * (j + 1) - 1) ce(R[t], v);
        }
    unsigned char* tab = (unsigned char*)smem + 73728 + (w * 16 + l15) * 32;
#pragma unroll
    for (int i = 0; i < 16; i++) { tab[i] = (unsigned char)(__float_as_uint(L0[i]) & 127u); tab[16 + i] = (unsigned char)(__float_as_uint(L1[i]) & 127u); }
    float ev[16]; float sum = 0.f;
#pragma unroll
    for (int t = 0; t < 16; t++) { ev[t] = __expf(R[t] - R[0]); sum += ev[t]; }
    const float inv = 1.f / sum;
    int eid[16];
#pragma unroll
    for (int t = 0; t < 16; t++) {
      unsigned code = __float_as_uint(R[t]) & 255u;
      eid[t] = (int)tab[code >> 4] * 128 + (int)tab[16 + (code & 15u)];
    }
    if (quad == 0) {
      int* eo = EIDX + (size_t)m * 128 + h * 16;
      float* go = GATE + (size_t)m * 128 + h * 16;
      float* uo = go + (size_t)MT * 128;
      float us[16], vs[16];
#pragma unroll
      for (int t = 0; t < 16; t++) { us[t] = USC[eid[t]]; vs[t] = USC[16384 + eid[t]]; }
#pragma unroll
      for (int t = 0; t < 16; t += 4) {
        *(int4*)(eo + t) = make_int4(eid[t], eid[t + 1], eid[t + 2], eid[t + 3]);
        *(float4*)(go + t) = make_float4(ev[t] * inv * vs[t], ev[t + 1] * inv * vs[t + 1], ev[t + 2] * inv * vs[t + 2], ev[t + 3] * inv * vs[t + 3]);
        *(float4*)(uo + t) = make_float4(us[t], us[t + 1], us[t + 2], us[t + 3]);
      }
    }
  }
}

DEV f32x2 fp8dot4(unsigned u, f32x2 xa, f32x2 xb, f32x2 d) {
  d += __builtin_amdgcn_cvt_pk_f32_fp8((int)u, false) * xa;
  d += __builtin_amdgcn_cvt_pk_f32_fp8((int)u, true) * xb;
  return d;
}
DEV void phase_peer_expert(const Params& p, int layer, int M, bool final_, int part, char* smem) {
  const bf16_t* H = WSP(bf16_t, OFF_H);
  const int* EIDX = layer ? WSP(int, L1_EIDX) : WSP(int, R_EIDX);
  const float* GATE = layer ? WSP(float, L1_GATE) : WSP(float, R_GATE);
  const float* USEL = GATE + (size_t)MT * 128;
  const unsigned char* U = layer ? WSP(unsigned char, OFF_U1) : WSP(unsigned char, OFF_U0);
  const unsigned char* V = layer ? WSP(unsigned char, OFF_V1) : WSP(unsigned char, OFF_V0);
  float* X = WSP(float, OFF_X);
  float* COEF = layer ? WSP(float, L1_COEF) : WSP(float, R_COEF);
  const float* mod = WSP(float, S_MOD) + (size_t)layer * 3 * 6144;
  const int tid = tidx(), lane = tid & 63, w = tid >> 6, g = lane >> 4, l16 = lane & 15;
  int* se = (int*)smem + w * 512;
  float* sg = (float*)(se + 128);
  float* su = sg + 128;
  float* coefs = su + 128;
  if (part == 0) {
  for (int m = blockIdx.x * 4 + w; m < M; m += gridDim.x * 4) {
    {
      int2 e2 = *(const int2*)(EIDX + (size_t)m * 128 + lane * 2);
      float2 g2 = *(const float2*)(GATE + (size_t)m * 128 + lane * 2);
      float2 u2 = *(const float2*)(USEL + (size_t)m * 128 + lane * 2);
      *(int2*)(se + lane * 2) = e2; *(float2*)(sg + lane * 2) = g2; *(float2*)(su + lane * 2) = u2;
    }
    const bf16_t* hrow = H + (size_t)m * LDH + l16 * 16;
    f32x2 xf[32];
#pragma unroll
    for (int c = 0; c < 4; c++) {
      uint4 a = *(const uint4*)(hrow + c * 256), bq = *(const uint4*)(hrow + c * 256 + 8);
      xf[c * 8 + 0] = (f32x2){bflo(a.x), bfhi(a.x)}; xf[c * 8 + 1] = (f32x2){bflo(a.y), bfhi(a.y)};
      xf[c * 8 + 2] = (f32x2){bflo(a.z), bfhi(a.z)}; xf[c * 8 + 3] = (f32x2){bflo(a.w), bfhi(a.w)};
      xf[c * 8 + 4] = (f32x2){bflo(bq.x), bfhi(bq.x)}; xf[c * 8 + 5] = (f32x2){bflo(bq.y), bfhi(bq.y)};
      xf[c * 8 + 6] = (f32x2){bflo(bq.z), bfhi(bq.z)}; xf[c * 8 + 7] = (f32x2){bflo(bq.w), bfhi(bq.w)};
    }
    __syncthreads();
    u32x4 cur[8], nxt[8];
    {
      const unsigned char* r0p = U + (size_t)se[g] * 1024 + l16 * 16;
      const unsigned char* r1p = U + (size_t)se[4 + g] * 1024 + l16 * 16;
#pragma unroll
      for (int c = 0; c < 4; c++) { cur[c] = *(const u32x4*)(r0p + c * 256); cur[4 + c] = *(const u32x4*)(r1p + c * 256); }
    }
#pragma unroll 2
    for (int st = 0; st < 16; st++) {
      if (st + 1 < 16) {
        const unsigned char* r0p = U + (size_t)se[(st + 1) * 8 + g] * 1024 + l16 * 16;
        const unsigned char* r1p = U + (size_t)se[(st + 1) * 8 + 4 + g] * 1024 + l16 * 16;
#pragma unroll
        for (int c = 0; c < 4; c++) { nxt[c] = *(const u32x4*)(r0p + c * 256); nxt[4 + c] = *(const u32x4*)(r1p + c * 256); }
      }
      f32x2 da = (f32x2){0.f, 0.f}, db = (f32x2){0.f, 0.f};
#pragma unroll
      for (int c = 0; c < 4; c++) {
        da = fp8dot4(cur[c][0], xf[c * 8 + 0], xf[c * 8 + 1], da); da = fp8dot4(cur[c][1], xf[c * 8 + 2], xf[c * 8 + 3], da);
        da = fp8dot4(cur[c][2], xf[c * 8 + 4], xf[c * 8 + 5], da); da = fp8dot4(cur[c][3], xf[c * 8 + 6], xf[c * 8 + 7], da);
        db = fp8dot4(cur[4 + c][0], xf[c * 8 + 0], xf[c * 8 + 1], db); db = fp8dot4(cur[4 + c][1], xf[c * 8 + 2], xf[c * 8 + 3], db);
        db = fp8dot4(cur[4 + c][2], xf[c * 8 + 4], xf[c * 8 + 5], db); db = fp8dot4(cur[4 + c][3], xf[c * 8 + 6], xf[c * 8 + 7], db);
      }
      float d0 = da.x + da.y, d1 = db.x + db.y;
      d0 += __shfl_xor(d0, 1); d1 += __shfl_xor(d1, 1);
      d0 += __shfl_xor(d0, 2); d1 += __shfl_xor(d1, 2);
      d0 += __shfl_xor(d0, 4); d1 += __shfl_xor(d1, 4);
      d0 += __shfl_xor(d0, 8); d1 += __shfl_xor(d1, 8);
      const int s0 = st * 8 + g, s1 = s0 + 4;
      d0 *= su[s0]; d1 *= su[s1];
      const float a0 = 0.5f * d0 * (1.f + erff(d0 * 0.70710678118f));
      const float a1 = 0.5f * d1 * (1.f + erff(d1 * 0.70710678118f));
      if (l16 == 0) { COEF[(size_t)m * 128 + s0] = sg[s0] * a0; COEF[(size_t)m * 128 + s1] = sg[s1] * a1; }
#pragma unroll
      for (int c = 0; c < 8; c++) cur[c] = nxt[c];
    }
    __syncthreads();
  }
  return;
  }
  for (int m = blockIdx.x * 4 + w; m < M; m += gridDim.x * 4) {
    {
      int2 e2 = *(const int2*)(EIDX + (size_t)m * 128 + lane * 2);
      float2 c2 = *(const float2*)(COEF + (size_t)m * 128 + lane * 2);
      *(int2*)(se + lane * 2) = e2; *(float2*)(coefs + lane * 2) = c2;
    }
    u32x4 cur[8], nxt[8];
    __syncthreads();
    f32x2 acc[32];
#pragma unroll
    for (int i = 0; i < 32; i++) acc[i] = (f32x2){0.f, 0.f};
    {
      const unsigned char* r0p = V + (size_t)se[g] * 1024 + l16 * 16;
      const unsigned char* r1p = V + (size_t)se[4 + g] * 1024 + l16 * 16;
#pragma unroll
      for (int c = 0; c < 4; c++) { cur[c] = *(const u32x4*)(r0p + c * 256); cur[4 + c] = *(const u32x4*)(r1p + c * 256); }
    }
#pragma unroll 2
    for (int st = 0; st < 16; st++) {
      if (st + 1 < 16) {
        const unsigned char* r0p = V + (size_t)se[(st + 1) * 8 + g] * 1024 + l16 * 16;
        const unsigned char* r1p = V + (size_t)se[(st + 1) * 8 + 4 + g] * 1024 + l16 * 16;
#pragma unroll
        for (int c = 0; c < 4; c++) { nxt[c] = *(const u32x4*)(r0p + c * 256); nxt[4 + c] = *(const u32x4*)(r1p + c * 256); }
      }
      const float c0 = coefs[st * 8 + g], c1 = coefs[st * 8 + 4 + g];
      const f32x2 ca = (f32x2){c0, c0}, cb = (f32x2){c1, c1};
#pragma unroll
      for (int c = 0; c < 4; c++) {
#pragma unroll
        for (int d = 0; d < 4; d++) {
          acc[c * 8 + d * 2 + 0] += ca * __builtin_amdgcn_cvt_pk_f32_fp8((int)cur[c][d], false);
          acc[c * 8 + d * 2 + 1] += ca * __builtin_amdgcn_cvt_pk_f32_fp8((int)cur[c][d], true);
          acc[c * 8 + d * 2 + 0] += cb * __builtin_amdgcn_cvt_pk_f32_fp8((int)cur[4 + c][d], false);
          acc[c * 8 + d * 2 + 1] += cb * __builtin_amdgcn_cvt_pk_f32_fp8((int)cur[4 + c][d], true);
        }
      }
#pragma unroll
      for (int c = 0; c < 8; c++) cur[c] = nxt[c];
    }
    __syncthreads();
#pragma unroll
    for (int i = 0; i < 32; i++) {
      acc[i].x += __shfl_xor(acc[i].x, 16); acc[i].x += __shfl_xor(acc[i].x, 32);
      acc[i].y += __shfl_xor(acc[i].y, 16); acc[i].y += __shfl_xor(acc[i].y, 32);
    }
    const int mr = (m < MM) ? (m >> 13) : 2;
    const float* m5 = mod + (size_t)mr * 6144 + 5 * 1024;
    float xn[16];
#pragma unroll
    for (int c = 0; c < 4; c++) {
      if (c == g) {
#pragma unroll
        for (int i = 0; i < 8; i++) { xn[2 * i] = acc[c * 8 + i].x; xn[2 * i + 1] = acc[c * 8 + i].y; }
      }
    }
    const int col = g * 256 + l16 * 16;
    float ss = 0.f;
#pragma unroll
    for (int q = 0; q < 4; q++) {
      float4 xa = *(const float4*)(X + (size_t)m * 1024 + col + q * 4);
      float4 ma = *(const float4*)(m5 + col + q * 4);
      xn[q * 4 + 0] = xa.x + ma.x * xn[q * 4 + 0]; xn[q * 4 + 1] = xa.y + ma.y * xn[q * 4 + 1];
      xn[q * 4 + 2] = xa.z + ma.z * xn[q * 4 + 2]; xn[q * 4 + 3] = xa.w + ma.w * xn[q * 4 + 3];
    }
#pragma unroll
    for (int i = 0; i < 16; i++) ss += xn[i] * xn[i];
    if (!final_) {
#pragma unroll
      for (int q = 0; q < 4; q++)
        *(float4*)(X + (size_t)m * 1024 + col + q * 4) = make_float4(xn[q * 4 + 0], xn[q * 4 + 1], xn[q * 4 + 2], xn[q * 4 + 3]);
      ss = wave_sum(ss);
      const float rinv = rsqrtf(ss * (1.f / 1024.f) + 1e-6f);
      const float* ng = p.in[I_N1G] + (layer + 1) * 1024;
      const float* nmod = WSP(float, S_MOD) + (size_t)(layer + 1) * 3 * 6144 + (size_t)mr * 6144;
      unsigned hv[8];
#pragma unroll
      for (int q = 0; q < 4; q++) {
        float4 g4 = *(const float4*)(ng + col + q * 4), sh = *(const float4*)(nmod + col + q * 4), sc = *(const float4*)(nmod + 1024 + col + q * 4);
        hv[q * 2 + 0] = pack2(xn[q * 4 + 0] * rinv * g4.x * (1.f + sc.x) + sh.x, xn[q * 4 + 1] * rinv * g4.y * (1.f + sc.y) + sh.y);
        hv[q * 2 + 1] = pack2(xn[q * 4 + 2] * rinv * g4.z * (1.f + sc.z) + sh.z, xn[q * 4 + 3] * rinv * g4.w * (1.f + sc.w) + sh.w);
      }
      bf16_t* hw = WSP(bf16_t, OFF_H) + (size_t)m * LDH + col;
      *(uint4*)(hw) = make_uint4(hv[0], hv[1], hv[2], hv[3]);
      *(uint4*)(hw + 8) = make_uint4(hv[4], hv[5], hv[6], hv[7]);
    } else {
      ss = wave_sum(ss);
      const float rinv = rsqrtf(ss * (1.f / 1024.f) + 1e-6f);
      const float* fg = p.in[I_FNG];
#pragma unroll
      for (int q = 0; q < 4; q++) {
        float4 g4 = *(const float4*)(fg + col + q * 4);
        *(float4*)(p.out + (size_t)m * 1024 + col + q * 4) = make_float4(xn[q * 4 + 0] * rinv * g4.x, xn[q * 4 + 1] * rinv * g4.y, xn[q * 4 + 2] * rinv * g4.z, xn[q * 4 + 3] * rinv * g4.w);
      }
    }
  }
}

struct EpiHG {
  bf16_t* QH; bf16_t* LF; bf16_t* LB; bf16_t* IH; bf16_t* GH; const float* lbp;
  DEV void operator()(int m, int n, f32x4 v) {
    const int seg = n >> 10, c = n & 1023;
    bf16_t* dst;
    if (seg == 0) dst = QH; else if (seg == 1) dst = LF; else if (seg == 2) dst = LB; else if (seg == 3) dst = IH; else dst = GH;
    if (seg == 1 || seg == 2) {
      const int dir = seg - 1;
#pragma unroll
      for (int r = 0; r < 4; r++) {
        float lb = sigm(lbp[(2 + dir) * 1024 + c + r] - lbp[dir * 1024 + c + r]);
        float ff = lb + (1.f - lb) * sigm(v[r]);
        v[r] = __logf(ff);
      }
    }
    uint2 o; o.x = pack2(v[0], v[1]); o.y = pack2(v[2], v[3]);
    *(uint2*)(dst + (size_t)m * 1024 + c) = o;
  }
};
DEV void phase_gemm_hgin(const Params& p, char* smem) {
  EpiHG epi{WSP(bf16_t, L1_QH), WSP(bf16_t, L1_LF), WSP(bf16_t, L1_LB), WSP(bf16_t, L1_IH), WSP(bf16_t, L1_GH), p.in[I_HGLB]};
  const int items = (MT / 128) * 40;
  for (int item = blockIdx.x; item < items; item += gridDim.x) {
    int mt = item / 40, nt = item - mt * 40;
    gemm_tile(WSP(bf16_t, OFF_H), LDH, WSP(bf16_t, S_WHGIN), LDH, 1024, mt * 128, nt * 128, epi, smem);
  }
}

DEV int hg_row0(int cidx, int b) { return (cidx < 4) ? (MM + b * 256 + cidx * 64) : (b * 8192 + (cidx - 4) * 64); }
DEV int hg_step(int cidx, int dir) {
  if (dir == 0) return cidx;
  return (cidx < 4) ? (3 - cidx) : (4 + 127 - (cidx - 4));
}

DEV void phase_hg_c1(const Params& p, char* smem) {
  const bf16_t* LFp = WSP(bf16_t, L1_LF); const bf16_t* LBp = WSP(bf16_t, L1_LB); const bf16_t* IH = WSP(bf16_t, L1_IH);
  bf16_t* DS = WSP(bf16_t, L1_DS); float* DEC = WSP(float, S_DECAY);
  bf16_t* RA = (bf16_t*)smem;
  bf16_t* RB = RA + 128 * 80;
  bf16_t* Vt = RB + 128 * 80;
  float* tot = (float*)(Vt + 128 * 80);
  const int tid = tidx(), lane = tid & 63, w = tid >> 6, l15 = lane & 15, quad = lane >> 4;
  const int wm = w >> 1, wn = w & 1;
  const int k = tid & 127, half = tid >> 7;
  const int items = 132 * 16;
  for (int item = blockIdx.x; item < items; item += gridDim.x) {
    const int cidx = item >> 4, bh = item & 15, b = bh >> 3, h = bh & 7;
    const int r0 = hg_row0(cidx, b);
    __syncthreads();
#pragma unroll
    for (int i = 0; i < 4; i++) {
      int id = tid + i * 256; int s = id >> 4, cc = id & 15;
      uint4 u = *(const uint4*)(IH + (size_t)(r0 + s) * 1024 + h * 128 + cc * 8);
      uint4 lf = *(const uint4*)(LFp + (size_t)(r0 + s) * 1024 + h * 128 + cc * 8);
      *(uint4*)(RB + s * 144 + cc * 8) = lf;
      bf16_t* vt = Vt + (cc * 8) * 80 + s;
      vt[0] = (bf16_t)(u.x & 0xffff); vt[80] = (bf16_t)(u.x >> 16); vt[160] = (bf16_t)(u.y & 0xffff); vt[240] = (bf16_t)(u.y >> 16);
      vt[320] = (bf16_t)(u.z & 0xffff); vt[400] = (bf16_t)(u.z >> 16); vt[480] = (bf16_t)(u.w & 0xffff); vt[560] = (bf16_t)(u.w >> 16);
    }
#pragma unroll 1
    for (int dir = 0; dir < 2; dir++) {
      bf16_t* stg = dir ? RA : RB;
      bf16_t* kot = dir ? RB : RA;
      if (dir == 1) {
        __syncthreads();
#pragma unroll
        for (int i = 0; i < 4; i++) {
          int id = tid + i * 256; int s = id >> 4, cc = id & 15;
          *(uint4*)(RA + s * 144 + cc * 8) = *(const uint4*)(LBp + (size_t)(r0 + s) * 1024 + h * 128 + cc * 8);
        }
      }
      __syncthreads();
      {
        float t = 0.f;
#pragma unroll 8
        for (int s = 0; s < 32; s++) t += bf2f(stg[(half * 32 + s) * 144 + k]);
        tot[half * 128 + k] = t;
      }
      __syncthreads();
      {
        const float tot0 = tot[k], total = tot0 + tot[128 + k];
        float run = half ? tot0 : 0.f;
        float lfr[32];
#pragma unroll
        for (int s = 0; s < 32; s++) lfr[s] = bf2f(stg[(half * 32 + s) * 144 + k]);
        if (dir == 1) __syncthreads();
        bf16_t* ko = kot + k * 80 + half * 32;
#pragma unroll
        for (int s2 = 0; s2 < 32; s2 += 2) {
          float o2[2];
#pragma unroll
          for (int u = 0; u < 2; u++) {
            const float lf = lfr[s2 + u];
            const float kk = 1.f - __expf(lf);
            float ex;
            if (dir == 0) { run += lf; ex = total - run; } else { ex = run; run += lf; }
            o2[u] = kk * __expf(ex);
          }
          *(unsigned*)(ko + s2) = pack2(o2[0], o2[1]);
        }
        if (half == 0) DEC[((size_t)(bh * 2 + dir) * 132 + hg_step(cidx, dir)) * 128 + k] = __expf(total);
      }
      __syncthreads();
      f32x4 acc[4][4];
#pragma unroll
      for (int i = 0; i < 4; i++)
#pragma unroll
        for (int j = 0; j < 4; j++) acc[i][j] = (f32x4){0.f, 0.f, 0.f, 0.f};
      mfma_lds<4, 4, 2>(kot, 80, Vt, 80, wm * 64, wn * 64, acc);
      bf16_t* dst = DS + ((size_t)(bh * 2 + dir) * 132 + hg_step(cidx, dir)) * 16384;
#pragma unroll
      for (int i = 0; i < 4; i++)
#pragma unroll
        for (int j = 0; j < 4; j++) {
          int kk = wm * 64 + i * 16 + quad * 4, dv = wn * 64 + j * 16 + l15;
          uint2 o; o.x = pack2(acc[i][j][0], acc[i][j][1]); o.y = pack2(acc[i][j][2], acc[i][j][3]);
          *(uint2*)(dst + dv * 128 + kk) = o;
        }
    }
  }
}

DEV void phase_hg_c2(const Params& p) {
  bf16_t* DS = WSP(bf16_t, L1_DS); const float* DEC = WSP(float, S_DECAY);
  for (int idx = blockIdx.x * 256 + tidx(); idx < 32 * 128 * 32; idx += gridDim.x * 256) {
    const int k4 = idx & 31, dv = (idx >> 5) & 127, chain = idx >> 12;
    bf16_t* dp = DS + (size_t)chain * 132 * 16384 + dv * 128 + k4 * 4;
    const float* dc = DEC + (size_t)chain * 132 * 128 + k4 * 4;
    float s0 = 0.f, s1 = 0.f, s2 = 0.f, s3 = 0.f;
    for (int st = 0; st < 132; st += 4) {
      uint2 d[4]; float4 dd[4];
#pragma unroll
      for (int u = 0; u < 4; u++) { d[u] = *(const uint2*)(dp + (size_t)(st + u) * 16384); dd[u] = *(const float4*)(dc + (size_t)(st + u) * 128); }
#pragma unroll
      for (int u = 0; u < 4; u++) {
        uint2 o; o.x = pack2(s0, s1); o.y = pack2(s2, s3);
        *(uint2*)(dp + (size_t)(st + u) * 16384) = o;
        s0 = dd[u].x * s0 + bflo(d[u].x); s1 = dd[u].y * s1 + bfhi(d[u].x);
        s2 = dd[u].z * s2 + bflo(d[u].y); s3 = dd[u].w * s3 + bfhi(d[u].y);
      }
    }
  }
}

DEV void phase_hg_c3(const Params& p, char* smem) {
  const bf16_t* QH = WSP(bf16_t, L1_QH); const bf16_t* LFp = WSP(bf16_t, L1_LF); const bf16_t* LBp = WSP(bf16_t, L1_LB);
  const bf16_t* IH = WSP(bf16_t, L1_IH); const bf16_t* GH = WSP(bf16_t, L1_GH); const bf16_t* DS = WSP(bf16_t, L1_DS);
  bf16_t* Rout = WSP(bf16_t, OFF_H);
  bf16_t* Qin = (bf16_t*)smem;
  bf16_t* Kin = Qin + 64 * 144;
  bf16_t* Vt = Kin + 64 * 144;
  bf16_t* Am = Vt + 128 * 80;
  bf16_t* SpT = Kin;
  float* Ob = (float*)smem;
  float* tot = (float*)(Am);
  const int tid = tidx(), lane = tid & 63, w = tid >> 6, l15 = lane & 15, quad = lane >> 4;
  const int wm = w >> 1, wn = w & 1;
  const int items = 128 * 16;
  for (int item = blockIdx.x; item < items; item += gridDim.x) {
    const int c = item >> 4, bh = item & 15, b = bh >> 3, h = bh & 7;
    const int cidx = c + 4;
    const int r0 = b * 8192 + c * 64;
    f32x4 acc[2][4];
#pragma unroll
    for (int i = 0; i < 2; i++)
#pragma unroll
      for (int j = 0; j < 4; j++) acc[i][j] = (f32x4){0.f, 0.f, 0.f, 0.f};
#pragma unroll 1
    for (int dir = 0; dir < 2; dir++) {
      __syncthreads();
      const int k = tid & 127, half = tid >> 7;
      {
        const bf16_t* lsrc = (dir ? LBp : LFp);
#pragma unroll
        for (int i = 0; i < 4; i++) {
          int id = tid + i * 256; int s = id >> 4, cc = id & 15;
          const size_t go = (size_t)(r0 + s) * 1024 + h * 128 + cc * 8;
          uint4 u = *(const uint4*)(IH + go);
          *(uint4*)(Kin + s * 144 + cc * 8) = *(const uint4*)(lsrc + go);
          *(uint4*)(Qin + s * 144 + cc * 8) = *(const uint4*)(QH + go);
          bf16_t* vt = Vt + (cc * 8) * 80 + s;
          vt[0] = (bf16_t)(u.x & 0xffff); vt[80] = (bf16_t)(u.x >> 16); vt[160] = (bf16_t)(u.y & 0xffff); vt[240] = (bf16_t)(u.y >> 16);
          vt[320] = (bf16_t)(u.z & 0xffff); vt[400] = (bf16_t)(u.z >> 16); vt[480] = (bf16_t)(u.w & 0xffff); vt[560] = (bf16_t)(u.w >> 16);
        }
      }
      u32x4 spr[8];
      {
        const bf16_t* sp = DS + ((size_t)(bh * 2 + dir) * 132 + hg_step(cidx, dir)) * 16384;
#pragma unroll
        for (int i = 0; i < 8; i++) { int id = tid + i * 256; int row = id >> 4, cc = id & 15; spr[i] = *(const u32x4*)(sp + row * 128 + cc * 8); }
      }
      __syncthreads();
      {
        float t = 0.f;
#pragma unroll 8
        for (int s = 0; s < 32; s++) t += bf2f(Kin[(half * 32 + s) * 144 + k]);
        tot[half * 128 + k] = t;
      }
      __syncthreads();
      if (dir == 0) {
        float run = half ? tot[k] : 0.f;
#pragma unroll 4
        for (int s = 0; s < 32; s++) {
          const int t = half * 32 + s;
          const float lf = bf2f(Kin[t * 144 + k]); run += lf;
          const float q = bf2f(Qin[t * 144 + k]);
          Qin[t * 144 + k] = f2bf(q * __expf(run));
          Kin[t * 144 + k] = f2bf((1.f - __expf(lf)) * __expf(-run));
        }
      } else {
        float run = half ? 0.f : tot[128 + k];
#pragma unroll 4
        for (int s = 31; s >= 0; s--) {
          const int t = half * 32 + s;
          const float lf = bf2f(Kin[t * 144 + k]); run += lf;
          const float q = bf2f(Qin[t * 144 + k]);
          Qin[t * 144 + k] = f2bf(q * __expf(run));
          Kin[t * 144 + k] = f2bf((1.f - __expf(lf)) * __expf(-run));
        }
      }
      __syncthreads();
      {
        f32x4 aa[2][2];
#pragma unroll
        for (int i = 0; i < 2; i++) { aa[i][0] = (f32x4){0.f, 0.f, 0.f, 0.f}; aa[i][1] = (f32x4){0.f, 0.f, 0.f, 0.f}; }
        mfma_lds<2, 2, 4>(Qin, 144, Kin, 144, wm * 32, wn * 32, aa);
#pragma unroll
        for (int i = 0; i < 2; i++)
#pragma unroll
          for (int j = 0; j < 2; j++)
#pragma unroll
            for (int r = 0; r < 4; r++) {
              int t = wm * 32 + i * 16 + quad * 4 + r, s = wn * 32 + j * 16 + l15;
              bool keep = dir ? (s >= t) : (s <= t);
              Am[t * 80 + s] = f2bf(keep ? aa[i][j][r] : 0.f);
            }
      }
      __syncthreads();
      mfma_lds<2, 4, 2>(Am, 80, Vt, 80, wm * 32, wn * 64, acc);
      __syncthreads();
#pragma unroll
      for (int i = 0; i < 8; i++) { int id = tid + i * 256; int row = id >> 4, cc = id & 15; *(u32x4*)(SpT + row * 144 + cc * 8) = spr[i]; }
      __syncthreads();
      mfma_lds<2, 4, 4>(Qin, 144, SpT, 144, wm * 32, wn * 64, acc);
    }
    __syncthreads();
#pragma unroll
    for (int i = 0; i < 2; i++)
#pragma unroll
      for (int j = 0; j < 4; j++)
#pragma unroll
        for (int r = 0; r < 4; r++) Ob[(wm * 32 + i * 16 + quad * 4 + r) * 132 + wn * 64 + j * 16 + l15] = acc[i][j][r];
    __syncthreads();
    {
      const int t = tid >> 2, q4 = tid & 3;
      float vals[32]; float ss = 0.f;
#pragma unroll
      for (int j = 0; j < 4; j++) {
        const int dv = (j * 4 + q4) * 8;
        float4 a = *(const float4*)(Ob + t * 132 + dv), bq = *(const float4*)(Ob + t * 132 + dv + 4);
        vals[j * 8 + 0] = a.x; vals[j * 8 + 1] = a.y; vals[j * 8 + 2] = a.z; vals[j * 8 + 3] = a.w;
        vals[j * 8 + 4] = bq.x; vals[j * 8 + 5] = bq.y; vals[j * 8 + 6] = bq.z; vals[j * 8 + 7] = bq.w;
      }
#pragma unroll
      for (int i = 0; i < 32; i++) ss += vals[i] * vals[i];
      ss += __shfl_xor(ss, 1); ss += __shfl_xor(ss, 2);
      const float rinv = rsqrtf(ss * (1.f / 128.f) + 1e-6f);
      const float* ng = p.in[I_HGNG];
#pragma unroll
      for (int j = 0; j < 4; j++) {
        const int col = h * 128 + (j * 4 + q4) * 8;
        uint4 gu = *(const uint4*)(GH + (size_t)(r0 + t) * 1024 + col);
        float4 na = *(const float4*)(ng + col), nb = *(const float4*)(ng + col + 4);
        float g0 = bflo(gu.x), g1 = bfhi(gu.x), g2 = bflo(gu.y), g3 = bfhi(gu.y), g4 = bflo(gu.z), g5 = bfhi(gu.z), g6 = bflo(gu.w), g7 = bfhi(gu.w);
        uint4 o;
        o.x = pack2(vals[j * 8 + 0] * rinv * na.x * g0 * sigm(g0), vals[j * 8 + 1] * rinv * na.y * g1 * sigm(g1));
        o.y = pack2(vals[j * 8 + 2] * rinv * na.z * g2 * sigm(g2), vals[j * 8 + 3] * rinv * na.w * g3 * sigm(g3));
        o.z = pack2(vals[j * 8 + 4] * rinv * nb.x * g4 * sigm(g4), vals[j * 8 + 5] * rinv * nb.y * g5 * sigm(g5));
        o.w = pack2(vals[j * 8 + 6] * rinv * nb.z * g6 * sigm(g6), vals[j * 8 + 7] * rinv * nb.w * g7 * sigm(g7));
        *(uint4*)(Rout + (size_t)(r0 + t) * LDH + col) = o;
      }
    }
  }
}


#define XB_TMO      128
#define XB_XCNT(j)  (256  + 64 * (j))
#define XB_XSUB(j)  (1280 + 64 * (j))
#define XB_XGEN(j)  (2304 + 64 * (j))
#define XB_TOP      3328
#define XB_TOPGEN   3392
#define XCD_BAR_WORDS 3456
#define XB_SPIN_CAP (1u << 22)
#define LAS __attribute__((address_space(3)))
DEV unsigned xb_ld(unsigned* p) { return __hip_atomic_load(p, __ATOMIC_RELAXED, __HIP_MEMORY_SCOPE_AGENT); }
DEV unsigned xb_add(unsigned* p, unsigned v) { return __hip_atomic_fetch_add(p, v, __ATOMIC_RELAXED, __HIP_MEMORY_SCOPE_AGENT); }
DEV unsigned xb_xcc_id() { return (unsigned)__builtin_amdgcn_s_getreg((3 << 11) | 20) & 0xFu; }
#define XB_SPIN(cond, bar) do { unsigned _sp = 0; while (cond) { __builtin_amdgcn_s_sleep(1); \
    if ((++_sp & 255u) == 0u) { if (xb_ld(&(bar)[XB_TMO])) break; if (_sp > XB_SPIN_CAP) { atomicAdd(&(bar)[XB_TMO], 1u); break; } } } } while (0)
struct XcdBarrier { unsigned* bar; unsigned x; volatile LAS unsigned* st; };
DEV XcdBarrier xcd_barrier_post(unsigned* bar, volatile LAS unsigned* st) {
  XcdBarrier b; b.bar = bar; b.x = xb_xcc_id(); b.st = st;
  if (threadIdx.x == 0) (void)xb_add(&bar[XB_XCNT(b.x)], 1u);
  return b;
}
DEV void xcd_barrier_complete(unsigned* bar, unsigned x, unsigned& nloc, unsigned& nx) {
  const unsigned G = gridDim.x * gridDim.y * gridDim.z;
  unsigned sum, cnt, mine, sp = 0u;
  for (;;) {
    sum = 0u; cnt = 0u; mine = 0u;
#pragma unroll
    for (unsigned j = 0; j < 16; ++j) { const unsigned c = xb_ld(&bar[XB_XCNT(j)]); sum += c; cnt += (c > 0u) ? 1u : 0u; mine = (j == x) ? c : mine; }
    if (sum == G) break;
    __builtin_amdgcn_s_sleep(1);
    if ((++sp & 255u) == 0u) { if (xb_ld(&bar[XB_TMO])) break; if (sp > XB_SPIN_CAP) { atomicAdd(&bar[XB_TMO], 1u); break; } }
  }
  nloc = mine > 0u ? mine : 1u; nx = cnt > 0u ? cnt : 1u;
}
DEV void xcd_barrier(const XcdBarrier& b) {
  asm volatile("s_waitcnt vmcnt(0)" ::: "memory");
  __syncthreads();
  if (threadIdx.x == 0) {
    unsigned* bar = b.bar;
    __builtin_amdgcn_s_waitcnt(0);
    unsigned nloc = b.st[0], nx = b.st[1];
    if (nloc == 0u) { xcd_barrier_complete(bar, b.x, nloc, nx); b.st[0] = nloc; b.st[1] = nx; }
    const unsigned old = xb_add(&bar[XB_XSUB(b.x)], 1u);
    const unsigned gen = old / nloc;
    if (old + 1u == (gen + 1u) * nloc) {
      __builtin_amdgcn_fence(__ATOMIC_RELEASE, "agent");
      asm volatile("s_waitcnt vmcnt(0)" ::: "memory");
      const unsigned og = xb_add(&bar[XB_TOP], 1u);
      const unsigned tg = og / nx;
      if (og + 1u == (tg + 1u) * nx) xb_add(&bar[XB_TOPGEN], 1u);
      else XB_SPIN(xb_ld(&bar[XB_TOPGEN]) == tg, bar);
      __builtin_amdgcn_fence(__ATOMIC_ACQUIRE, "agent");
      xb_add(&bar[XB_XGEN(b.x)], 1u);
      asm volatile("s_waitcnt vmcnt(0)" ::: "memory");
    } else {
      XB_SPIN(xb_ld(&bar[XB_XGEN(b.x)]) == gen, bar);
      __builtin_amdgcn_fence(__ATOMIC_ACQUIRE, "agent");
      asm volatile("s_waitcnt vmcnt(0)" ::: "memory");
    }
  }
  __syncthreads();
}

#define NPHASE 21
#define SMEM_BYTES 80896
#define TAB_OFF 80640
DEV void park_params(const Params& p, char* smem) {
  if (tidx() == 0) {
    unsigned long long* tab = (unsigned long long*)(smem + TAB_OFF);
#pragma unroll
    for (int i = 0; i < 27; i++) tab[i] = (unsigned long long)p.in[i];
    tab[27] = (unsigned long long)p.ws;
    tab[28] = (unsigned long long)p.out;
  }
  __syncthreads();
}
DEV unsigned long long tab_get(const char* smem, int i) {
  const unsigned* t = (const unsigned*)(smem + TAB_OFF) + 2 * i;
  unsigned lo = __builtin_amdgcn_readfirstlane(t[0]), hi = __builtin_amdgcn_readfirstlane(t[1]);
  return ((unsigned long long)hi << 32) | lo;
}
typedef __attribute__((address_space(1))) char gchar_t;
DEV void fetch_params(Params& q, const char* smem) {
#pragma unroll
  for (int i = 0; i < 27; i++) q.in[i] = (const float*)(char*)(gchar_t*)tab_get(smem, i);
  q.ws = (char*)(gchar_t*)tab_get(smem, 27);
  q.out = (float*)(char*)(gchar_t*)tab_get(smem, 28);
}
DEV void run_phase(int ph, char* smem) {
#ifdef ONLYPH
  if (ph != ONLYPH) return;
#endif
  Params p;
  fetch_params(p, smem);
  switch (ph) {
    case 0: phase_prep(p, smem); break;
    case 1: phase_norm(p, 0, 0, MT, true); break;
    case 2: phase_gemm_win(p, smem); break;
    case 3: phase_post1(p); break;
    case 4: phase_qkv_conv(p, smem); break;
    case 5: phase_attn(p, smem); break;
    case 6: phase_gemm_out(p, 0, smem); break;
    case 7: phase_norm(p, 0, 1, MT, false); break;
    case 8: phase_gemm_pq(p, 0, MT, smem); break;
    case 9: phase_peer_score(p, 0, MT, smem); break;
    case 10: phase_peer_expert(p, 0, MT, false, 1, smem); break;
    case 110: phase_peer_expert(p, 0, MT, false, 0, smem); break;
    case 11: break;
    case 12: phase_gemm_hgin(p, smem); break;
    case 13: phase_hg_c1(p, smem); break;
    case 14: phase_hg_c2(p); break;
    case 15: phase_hg_c3(p, smem); break;
    case 16: phase_gemm_out(p, 1, smem); break;
    case 17: phase_norm(p, 1, 1, MM, false); break;
    case 18: phase_gemm_pq(p, 1, MM, smem); break;
    case 19: phase_peer_score(p, 1, MM, smem); break;
    case 20: phase_peer_expert(p, 1, MM, true, 1, smem); break;
    case 120: phase_peer_expert(p, 1, MM, true, 0, smem); break;
    default: break;
  }
}

#if MEGA
#define OFF_BAR (492 * MIB)
__global__ void __launch_bounds__(256, 2) fwd_megakernel(Params p) {
  __shared__ __attribute__((aligned(16))) char smem[SMEM_BYTES];
  __shared__ uint4 xb_words;
  cg::grid_group grid = cg::this_grid();
  if (threadIdx.x == 0) xb_words = make_uint4(0u, 0u, 0u, 0u);
  park_params(p, smem);
  XcdBarrier xb = xcd_barrier_post((unsigned*)(p.ws + OFF_BAR), (volatile LAS unsigned*)&xb_words);
#pragma unroll 1
  for (int ph = 0; ph < NPHASE; ph++) {
    if (ph == 11) continue;
    if (ph == 10 || ph == 20) { run_phase(ph + 100, smem); xcd_barrier(xb); }
    run_phase(ph, smem);
    if (ph + 1 < NPHASE) xcd_barrier(xb);
    if (p.ws == nullptr) grid.sync();
  }
}
#else
__global__ void __launch_bounds__(256, 2) fwd_phase(Params p, int ph) {
  __shared__ __attribute__((aligned(16))) char smem[SMEM_BYTES];
  park_params(p, smem);
  run_phase(ph, smem);
}
#endif

extern "C" void kernel_launch(void* const* d_in, const int* in_sizes, int n_in, void* d_out, int out_size, void* d_ws,
                              size_t ws_size, hipStream_t stream) {
  Params p{};
  for (int i = 0; i < 27; i++) p.in[i] = (const float*)d_in[i];
  p.ws = (char*)d_ws;
  p.out = (float*)d_out;
  if (ws_size < WS_NEED) { fprintf(stderr, "workspace too small: %zu\n", ws_size); return; }
#if MEGA
  static int grid_blocks = 0;
  if (!grid_blocks) {
    int dev = 0, cus = 0, per_cu = 0;
    hipGetDevice(&dev);
    hipDeviceGetAttribute(&cus, hipDeviceAttributeMultiprocessorCount, dev);
    hipOccupancyMaxActiveBlocksPerMultiprocessor(&per_cu, fwd_megakernel, 256, 0);
    if (per_cu > 2) per_cu = 2;
    grid_blocks = cus * per_cu;
  }
  hipMemsetAsync((char*)d_ws + OFF_BAR, 0, XCD_BAR_WORDS * 4, stream);
  void* args[] = {&p};
  hipError_t e = hipLaunchCooperativeKernel((void*)fwd_megakernel, dim3(grid_blocks), dim3(256), args, 0, stream);
  if (e != hipSuccess) fprintf(stderr, "cooperative launch failed: %s (grid %d)\n", hipGetErrorString(e), grid_blocks);
#else
  for (int ph = 0; ph < NPHASE; ph++) fwd_phase<<<dim3(1024), dim3(256), 0, stream>>>(p, ph);
#endif
}
```

```cpp
#include <hip/hip_runtime.h>
#include <hip/hip_cooperative_groups.h>
#include <stdint.h>
#include <stdio.h>
namespace cg = cooperative_groups;

#ifndef MEGA
#define MEGA 1
#endif

typedef unsigned short bf16_t;
typedef __attribute__((ext_vector_type(8))) short bf16x8;
typedef __attribute__((ext_vector_type(4))) float f32x4;
typedef __attribute__((ext_vector_type(2))) __bf16 bf2_t;
typedef __attribute__((ext_vector_type(4))) unsigned u32x4;
typedef __attribute__((ext_vector_type(2))) float f32x2;

#define DEV __device__ __forceinline__
#define MM 16384
#define MT 16896
#define MIB ((size_t)1 << 20)

#define OFF_X     ((size_t)0)
#define OFF_H     (66 * MIB)
#define OFF_U1    (103 * MIB)
#define OFF_V1    (131 * MIB)
#define OFF_SMALL (163 * MIB)
#define OFF_U0    (195 * MIB)
#define OFF_V0    (227 * MIB)
#define OFF_R     (259 * MIB)
#define LDH 1088
#define QMIB ((size_t)262144)
#define S_WIN0   (OFF_SMALL)
#define S_WUQ    (OFF_SMALL + 13 * QMIB)
#define S_WUKV   (OFF_SMALL + 13 * QMIB + 393216)
#define S_WOUT0  (OFF_SMALL + 15 * QMIB + 131072)
#define S_WHGIN  (OFF_SMALL + 24 * QMIB)
#define S_WHGOUT (OFF_SMALL + 66 * QMIB + 131072)
#define S_WPQ    (OFF_SMALL + 75 * QMIB)
#define S_SUBK   (OFF_SMALL + 109 * QMIB)
#define S_MOD    (OFF_SMALL + 113 * QMIB)
#define S_ROPEC  (OFF_SMALL + 114 * QMIB)
#define S_ROPES  (OFF_SMALL + 116 * QMIB)
#define S_DECAY  (OFF_SMALL + 118 * QMIB)
#define S_UVSC   (OFF_SMALL + 126 * QMIB + 131072)
#define R_P0   (OFF_R)
#define R_QN   (OFF_R + 50 * MIB)
#define R_KVN  (OFF_R + 59 * MIB)
#define R_YG   (OFF_R + 64 * MIB)
#define R_Q    (OFF_R + 81 * MIB)
#define R_QC   (OFF_R + 105 * MIB)
#define R_K    (OFF_R + 106 * MIB)
#define R_VT   (OFF_R + 131 * MIB)
#define R_MIX  (OFF_R + 148 * MIB)
#define R_EIDX (OFF_R + 184 * MIB)
#define R_GATE (OFF_R + 193 * MIB)
#define R_COEF (OFF_R + 210 * MIB)
#define R_PQ   (OFF_R)
#define L1_QH   (195 * MIB)
#define L1_LF   (228 * MIB)
#define L1_LB   (261 * MIB)
#define L1_IH   (294 * MIB)
#define L1_GH   (327 * MIB)
#define L1_DS   (360 * MIB)
#define L1_PQ   (195 * MIB)
#define L1_EIDX (261 * MIB)
#define L1_GATE (270 * MIB)
#define L1_COEF (287 * MIB)
#define WS_NEED (493 * MIB)

struct Params {
  const float* in[27];
  char* ws;
  float* out;
};
#define WSP(type, off) ((type*)(p.ws + (size_t)(off)))

enum { I_X = 0, I_C, I_CTX, I_CCTX, I_ADAW, I_ADAB, I_N1G, I_N2G, I_WIN, I_QG, I_WUQ, I_KVG, I_WUKV, I_CONVW, I_CONVB,
       I_LNG, I_LNB, I_WOUT, I_HGWIN, I_HGLB, I_HGNG, I_HGWOUT, I_PWQ, I_PSK, I_PU, I_PV, I_FNG };

DEV int tidx() { int t = threadIdx.x; asm volatile("" : "+v"(t)); return t; }
DEV unsigned short f2bf(float x) { return __builtin_bit_cast(unsigned short, (__bf16)x); }
DEV float bf2f(unsigned short b) { return __uint_as_float(((unsigned)b) << 16); }
DEV unsigned pack2(float a, float b) { f32x2 v = {a, b}; return __builtin_bit_cast(unsigned, __builtin_convertvector(v, bf2_t)); }
DEV float bflo(unsigned u) { return __uint_as_float(u << 16); }
DEV float bfhi(unsigned u) { return __uint_as_float(u & 0xffff0000u); }
DEV float wave_sum(float v) {
#pragma unroll
  for (int o = 32; o > 0; o >>= 1) v += __shfl_xor(v, o);
  return v;
}
DEV float sigm(float x) { return 1.f / (1.f + __expf(-x)); }
DEV f32x4 mfma16(bf16x8 a, bf16x8 b, f32x4 c) { return __builtin_amdgcn_mfma_f32_16x16x32_bf16(a, b, c, 0, 0, 0); }
DEV float dot2bf(unsigned a, unsigned b, float c) {
  return __builtin_amdgcn_fdot2_f32_bf16(__builtin_bit_cast(bf2_t, a), __builtin_bit_cast(bf2_t, b), c, false);
}

template <int TI, int TJ, int KS>
DEV void mfma_lds(const bf16_t* Arows, int lda, const bf16_t* Brows, int ldb, int i0, int j0, f32x4 (&acc)[TI][TJ]) {
  const int lane = tidx() & 63, l15 = lane & 15, quad = lane >> 4;
#pragma unroll
  for (int ks = 0; ks < KS; ks++) {
    bf16x8 af[TI], bfr[TJ];
#pragma unroll
    for (int i = 0; i < TI; i++) af[i] = *(const bf16x8*)(Arows + (i0 + i * 16 + l15) * lda + ks * 32 + quad * 8);
#pragma unroll
    for (int j = 0; j < TJ; j++) bfr[j] = *(const bf16x8*)(Brows + (j0 + j * 16 + l15) * ldb + ks * 32 + quad * 8);
#pragma unroll
    for (int i = 0; i < TI; i++)
#pragma unroll
      for (int j = 0; j < TJ; j++) acc[i][j] = mfma16(af[i], bfr[j], acc[i][j]);
  }
}

#define GLD 80
template <class Epi>
DEV void gemm_tile(const bf16_t* __restrict__ A, int lda, const bf16_t* __restrict__ Bt, int ldb, int K, int m0, int n0,
                   Epi& epi, char* smem) {
  bf16_t* As = (bf16_t*)smem;
  bf16_t* Bs = As + 128 * GLD;
  const int tid = tidx(), lane = tid & 63, w = tid >> 6, wm = w >> 1, wn = w & 1;
  const int l15 = lane & 15, quad = lane >> 4;
  f32x4 acc[4][4];
#pragma unroll
  for (int i = 0; i < 4; i++)
#pragma unroll
    for (int j = 0; j < 4; j++) acc[i][j] = (f32x4){0.f, 0.f, 0.f, 0.f};
  u32x4 ra0[4], rb0[4], ra1[4], rb1[4];
  const int nk = K >> 6;
  const int lrow = tid >> 3, lcc = tid & 7;
  const bf16_t* Ap = A + (size_t)(m0 + lrow) * lda + lcc * 8;
  const bf16_t* Bp = Bt + (size_t)(n0 + lrow) * ldb + lcc * 8;
#define G_LOAD(RA, RB, KT) { _Pragma("unroll") for (int i = 0; i < 4; i++) { \
      RA[i] = *(const u32x4*)(Ap + (size_t)(i * 32) * lda + (KT) * 64); RB[i] = *(const u32x4*)(Bp + (size_t)(i * 32) * ldb + (KT) * 64); } }
#define G_STORE(RA, RB) { _Pragma("unroll") for (int i = 0; i < 4; i++) { \
      *(u32x4*)(As + (lrow + i * 32) * GLD + lcc * 8) = RA[i]; *(u32x4*)(Bs + (lrow + i * 32) * GLD + lcc * 8) = RB[i]; } }
  G_LOAD(ra0, rb0, 0);
  G_LOAD(ra1, rb1, 1);
  for (int kt = 0; kt < nk; kt += 2) {
    __syncthreads();
    G_STORE(ra0, rb0);
    __syncthreads();
    if (kt + 2 < nk) G_LOAD(ra0, rb0, kt + 2);
    mfma_lds<4, 4, 2>(Bs, GLD, As, GLD, wn * 64, wm * 64, acc);
    __syncthreads();
    G_STORE(ra1, rb1);
    __syncthreads();
    if (kt + 3 < nk) G_LOAD(ra1, rb1, kt + 3);
    mfma_lds<4, 4, 2>(Bs, GLD, As, GLD, wn * 64, wm * 64, acc);
  }
#undef G_LOAD
#undef G_STORE
#pragma unroll
  for (int i = 0; i < 4; i++)
#pragma unroll
    for (int j = 0; j < 4; j++) epi(m0 + wm * 64 + j * 16 + l15, n0 + wn * 64 + i * 16 + quad * 4, acc[i][j]);
}


DEV bool xcd_tile(int item, int mtiles, int NT, int& mt, int& nt) {
  const int nng = NT >> 3;
  const int xcd = item & 7, j = item >> 3;
  const int group = (j >> 6) * 8 + xcd, within = j & 63;
  const int mg = group / nng, ng = group - mg * nng;
  mt = mg * 8 + (within >> 3); nt = ng * 8 + (within & 7);
  return mt < mtiles;
}
DEV int xcd_tile_items(int mtiles, int NT) { const int groups = ((mtiles + 7) >> 3) * (NT >> 3); return ((groups + 7) >> 3) * 8 * 64; }

DEV void transpose_tile(const float* __restrict__ W, int K, int N, bf16_t* __restrict__ Wt, int ldt, int tile, char* smem) {
  float* sm = (float*)smem;
  const int ntn = N >> 5;
  const int kt = tile / ntn, nt = tile - kt * ntn;
  const int tx = tidx() & 31, ty = tidx() >> 5;
  __syncthreads();
#pragma unroll
  for (int i = 0; i < 4; i++) { int k = ty + i * 8; sm[k * 33 + tx] = W[(size_t)(kt * 32 + k) * N + nt * 32 + tx]; }
  __syncthreads();
#pragma unroll
  for (int i = 0; i < 4; i++) { int n = ty + i * 8; Wt[(size_t)(nt * 32 + n) * ldt + kt * 32 + tx] = f2bf(sm[tx * 33 + n]); }
}
DEV void convert_chunk(const float* __restrict__ src, bf16_t* __restrict__ dst, int chunk) {
  size_t o = (size_t)chunk * 2048 + tidx() * 8;
  float4 a = *(const float4*)(src + o), b = *(const float4*)(src + o + 4);
  uint4 r; r.x = pack2(a.x, a.y); r.y = pack2(a.z, a.w); r.z = pack2(b.x, b.y); r.w = pack2(b.z, b.w);
  *(uint4*)(dst + o) = r;
}

#define NT_WIN   1440
#define NT_WUQ   192
#define NT_WUKV  128
#define NT_WOUT  1024
#define NT_HGIN  5120
#define NT_HGOUT 1024
#define NT_WPQ   4096
#define P0_TR (NT_WIN + NT_WUQ + NT_WUKV + NT_WOUT + NT_HGIN + NT_HGOUT + NT_WPQ)
#define P0_CV_SUBK 256
#define P0_CV_U 2048
#define P0_CV_V 2048
#define P0_ZP 51
#define P0_MOD 384
#define P0_ROPE 512
#define P0_ITEMS (P0_TR + P0_CV_SUBK + P0_CV_U + P0_CV_V + P0_ZP + P0_MOD + P0_ROPE)

DEV void phase_prep(const Params& p, char* smem) {
  for (int item = blockIdx.x; item < P0_ITEMS; item += gridDim.x) {
    int it = item;
    if (it < P0_TR) {
      if (it < NT_WIN) { transpose_tile(p.in[I_WIN], 1024, 1440, WSP(bf16_t, S_WIN0), LDH, it, smem); continue; }
      it -= NT_WIN;
      if (it < NT_WUQ) { transpose_tile(p.in[I_WUQ], 256, 768, WSP(bf16_t, S_WUQ), 256, it, smem); continue; }
      it -= NT_WUQ;
      if (it < NT_WUKV) { transpose_tile(p.in[I_WUKV], 128, 1024, WSP(bf16_t, S_WUKV), 128, it, smem); continue; }
      it -= NT_WUKV;
      if (it < NT_WOUT) { transpose_tile(p.in[I_WOUT], 1024, 1024, WSP(bf16_t, S_WOUT0), LDH, it, smem); continue; }
      it -= NT_WOUT;
      if (it < NT_HGIN) { transpose_tile(p.in[I_HGWIN], 1024, 5120, WSP(bf16_t, S_WHGIN), LDH, it, smem); continue; }
      it -= NT_HGIN;
      if (it < NT_HGOUT) { transpose_tile(p.in[I_HGWOUT], 1024, 1024, WSP(bf16_t, S_WHGOUT), LDH, it, smem); continue; }
      it -= NT_HGOUT;
      int l = it >> 11; it &= 2047;
      transpose_tile(p.in[I_PWQ] + (size_t)l * 1024 * 2048, 1024, 2048, WSP(bf16_t, S_WPQ) + (size_t)l * 2048 * LDH, LDH, it, smem);
      continue;
    }
    it -= P0_TR;
    if (it < P0_CV_SUBK) { convert_chunk(p.in[I_PSK], WSP(bf16_t, S_SUBK), it); continue; }
    it -= P0_CV_SUBK;
    if (it < P0_CV_U + P0_CV_V) {
      const int isv = it >= P0_CV_U; const int r16 = isv ? it - P0_CV_U : it;
      const int lane = tidx() & 63;
      const int rowb = r16 * 16 + (tidx() >> 6) * 4;
      const float* src = (isv ? p.in[I_PV] : p.in[I_PU]) + (size_t)rowb * 1024 + lane * 16;
      float4 v[4][4];
#pragma unroll
      for (int r = 0; r < 4; r++)
#pragma unroll
        for (int q = 0; q < 4; q++) v[r][q] = *(const float4*)(src + (size_t)r * 1024 + q * 4);
#pragma unroll
      for (int r = 0; r < 4; r++) {
        float mx = 0.f;
#pragma unroll
        for (int q = 0; q < 4; q++) mx = fmaxf(mx, fmaxf(fmaxf(fabsf(v[r][q].x), fabsf(v[r][q].y)), fmaxf(fabsf(v[r][q].z), fabsf(v[r][q].w))));
#pragma unroll
        for (int o = 32; o > 0; o >>= 1) mx = fmaxf(mx, __shfl_xor(mx, o));
        mx = fmaxf(mx, 1e-30f);
        const float sc = exp2f(floorf(log2f(384.f / mx)));
        unsigned ow[4];
#pragma unroll
        for (int q = 0; q < 4; q++) {
          int t = __builtin_amdgcn_cvt_pk_fp8_f32(v[r][q].x * sc, v[r][q].y * sc, 0, false);
          t = __builtin_amdgcn_cvt_pk_fp8_f32(v[r][q].z * sc, v[r][q].w * sc, t, true);
          ow[q] = (unsigned)t;
        }
        const int row = rowb + r; const int l = row >> 14, e = row & 16383;
        unsigned char* dst = isv ? (l ? WSP(unsigned char, OFF_V1) : WSP(unsigned char, OFF_V0)) : (l ? WSP(unsigned char, OFF_U1) : WSP(unsigned char, OFF_U0));
        *(uint4*)(dst + (size_t)e * 1024 + lane * 16) = make_uint4(ow[0], ow[1], ow[2], ow[3]);
        if (lane == 0) WSP(float, S_UVSC)[(l * 2 + isv) * 16384 + e] = 1.f / sc;
      }
      continue;
    }
    it -= P0_CV_U;
    it -= P0_CV_V;
    if (it < P0_ZP) {
      bf16_t* dst = WSP(bf16_t, S_WIN0) + (size_t)1440 * LDH + (size_t)it * 2048 + tidx() * 8;
      *(uint4*)dst = make_uint4(0u, 0u, 0u, 0u);
      continue;
    }
    it -= P0_ZP;
    if (it < P0_MOD) {
      const int l = it / 192, nb = it - l * 192;
      const int col = tidx() & 31, kg = tidx() >> 5;
      const int n = nb * 32 + col;
      const float* W = p.in[I_ADAW] + (size_t)l * 1024 * 6144;
      float* sv = (float*)smem;
      float* red = sv + 3072;
      __syncthreads();
      for (int i = tidx(); i < 3072; i += 256) {
        const int r = i >> 10, k = i & 1023;
        const float c = (r < 2) ? p.in[I_C][r * 1024 + k] : p.in[I_CCTX][k];
        sv[i] = c * sigm(c);
      }
      __syncthreads();
      float a0 = 0.f, a1 = 0.f, a2 = 0.f;
      const float* wp = W + (size_t)(kg * 128) * 6144 + n;
#pragma unroll 1
      for (int kb = 0; kb < 128; kb += 32) {
        float wv[32];
#pragma unroll
        for (int u = 0; u < 32; u++) wv[u] = wp[(size_t)(kb + u) * 6144];
#pragma unroll
        for (int u = 0; u < 32; u++) {
          const int k = kg * 128 + kb + u;
          a0 += sv[k] * wv[u]; a1 += sv[1024 + k] * wv[u]; a2 += sv[2048 + k] * wv[u];
        }
      }
      red[(kg * 32 + col) * 3 + 0] = a0; red[(kg * 32 + col) * 3 + 1] = a1; red[(kg * 32 + col) * 3 + 2] = a2;
      __syncthreads();
      if (tidx() < 96) {
        int r = tidx() >> 5, cc = tidx() & 31;
        float sum = 0.f;
        for (int g = 0; g < 8; g++) sum += red[(g * 32 + cc) * 3 + r];
        int nn = nb * 32 + cc;
        WSP(float, S_MOD)[(size_t)(l * 3 + r) * 6144 + nn] = sum + p.in[I_ADAB][l * 6144 + nn];
      }
      continue;
    }
    it -= P0_MOD;
    {
      int idx = it * 256 + tidx();
      int t = idx >> 4, i = idx & 15;
      int f = i & 7;
      float pos = (i < 8) ? (float)(t >> 6) : (float)(t & 63);
      float inv = powf(10000.f, -(float)(2 * f) / 16.f);
      float ang = pos * inv;
      WSP(float, S_ROPEC)[idx] = cosf(ang);
      WSP(float, S_ROPES)[idx] = sinf(ang);
    }
  }
}

DEV void phase_norm(const Params& p, int layer, int which, int M, bool from_inputs) {
  const float* g = p.in[which ? I_N2G : I_N1G] + layer * 1024;
  const float* mod = WSP(float, S_MOD) + (size_t)layer * 3 * 6144;
  const int shift_c = which ? 3 : 0, scale_c = which ? 4 : 1;
  const float* X = WSP(float, OFF_X);
  bf16_t* H = WSP(bf16_t, OFF_H);
  const int wave = tidx() >> 6, lane = tidx() & 63;
  for (int row = blockIdx.x * 4 + wave; row < M; row += gridDim.x * 4) {
    const float* src; int mr;
    if (row < MM) { src = (from_inputs ? p.in[I_X] : X) + (size_t)row * 1024; mr = row >> 13; }
    else { src = from_inputs ? (p.in[I_CTX] + (size_t)(row - MM) * 1024) : (X + (size_t)row * 1024); mr = 2; }
    float4 v[4]; float ss = 0.f;
#pragma unroll
    for (int i = 0; i < 4; i++) {
      v[i] = ((const float4*)src)[lane + i * 64];
      ss += v[i].x * v[i].x + v[i].y * v[i].y + v[i].z * v[i].z + v[i].w * v[i].w;
    }
    ss = wave_sum(ss);
    const float rinv = rsqrtf(ss * (1.f / 1024.f) + 1e-6f);
    const float* msh = mod + (size_t)mr * 6144 + shift_c * 1024;
    const float* msc = mod + (size_t)mr * 6144 + scale_c * 1024;
#pragma unroll
    for (int i = 0; i < 4; i++) {
      int c4 = lane + i * 64;
      float4 g4 = ((const float4*)g)[c4], sh = ((const float4*)msh)[c4], sc = ((const float4*)msc)[c4];
      float o0 = v[i].x * rinv * g4.x * (1.f + sc.x) + sh.x;
      float o1 = v[i].y * rinv * g4.y * (1.f + sc.y) + sh.y;
      float o2 = v[i].z * rinv * g4.z * (1.f + sc.z) + sh.z;
      float o3 = v[i].w * rinv * g4.w * (1.f + sc.w) + sh.w;
      uint2 r; r.x = pack2(o0, o1); r.y = pack2(o2, o3);
      *(uint2*)(H + (size_t)row * LDH + c4 * 4) = r;
    }
  }
}

struct EpiP0 {
  bf16_t* P0;
  DEV void operator()(int m, int n, f32x4 v) {
    if (n < 1440) { uint2 r; r.x = pack2(v[0], v[1]); r.y = pack2(v[2], v[3]); *(uint2*)(P0 + (size_t)m * 1536 + n) = r; }
  }
};
DEV void phase_gemm_win(const Params& p, char* smem) {
  EpiP0 epi{WSP(bf16_t, R_P0)};
  const int NTL = 12, items = (MT / 128) * NTL;
  for (int item = blockIdx.x; item < items; item += gridDim.x) {
    int mt = item / NTL, nt = item - mt * NTL;
    gemm_tile(WSP(bf16_t, OFF_H), LDH, WSP(bf16_t, S_WIN0), LDH, 1024, mt * 128, nt * 128, epi, smem);
  }
}

DEV void phase_post1(const Params& p) {
  const bf16_t* P0 = WSP(bf16_t, R_P0);
  bf16_t* QN = WSP(bf16_t, R_QN); bf16_t* KVN = WSP(bf16_t, R_KVN); bf16_t* YG = WSP(bf16_t, R_YG);
  bf16_t* Kb = WSP(bf16_t, R_K);
  const float* rc = WSP(float, S_ROPEC); const float* rs = WSP(float, S_ROPES);
  const float* qg = p.in[I_QG]; const float* kvg = p.in[I_KVG];
  const int wave = tidx() >> 6, lane = tidx() & 63;
  for (int row = blockIdx.x * 4 + wave; row < MT; row += gridDim.x * 4) {
    const bf16_t* pr = P0 + (size_t)row * 1536;
    {
      uint2 u = *(const uint2*)(pr + lane * 4);
      float a0 = bflo(u.x), a1 = bfhi(u.x), a2 = bflo(u.y), a3 = bfhi(u.y);
      float ss = wave_sum(a0 * a0 + a1 * a1 + a2 * a2 + a3 * a3);
      float rinv = rsqrtf(ss * (1.f / 256.f) + 1e-6f);
      float4 g4 = ((const float4*)qg)[lane];
      uint2 r; r.x = pack2(a0 * rinv * g4.x, a1 * rinv * g4.y); r.y = pack2(a2 * rinv * g4.z, a3 * rinv * g4.w);
      *(uint2*)(QN + (size_t)row * 256 + lane * 4) = r;
    }
    {
      unsigned u = *(const unsigned*)(pr + 256 + lane * 2);
      float a0 = bflo(u), a1 = bfhi(u);
      float ss = wave_sum(a0 * a0 + a1 * a1);
      float rinv = rsqrtf(ss * (1.f / 128.f) + 1e-6f);
      float2 g2 = ((const float2*)kvg)[lane];
      *(unsigned*)(KVN + (size_t)row * 128 + lane * 2) = pack2(a0 * rinv * g2.x, a1 * rinv * g2.y);
    }
    if (lane < 16) {
      unsigned u = *(const unsigned*)(pr + 384 + lane * 2);
      float x0 = bflo(u), x1 = bfhi(u);
      int b, pos;
      if (row < MM) {
        b = row >> 13; int t = row & 8191; pos = 256 + t;
        float c = rc[t * 16 + lane], s = rs[t * 16 + lane];
        float y0 = x0 * c - x1 * s, y1 = x0 * s + x1 * c; x0 = y0; x1 = y1;
      } else { int rr = row - MM; b = rr >> 8; pos = rr & 255; }
      unsigned o = pack2(x0, x1);
#pragma unroll
      for (int h = 0; h < 8; h++) *(unsigned*)(Kb + ((size_t)(b * 8 + h) * 8448 + pos) * 96 + 64 + lane * 2) = o;
    }
    {
      uint4 ua = *(const uint4*)(pr + 416 + lane * 8);
      uint4 ug = *(const uint4*)(pr + 416 + 512 + lane * 8);
      uint4 r;
      r.x = pack2(bflo(ua.x) * sigm(bflo(ug.x)), bfhi(ua.x) * sigm(bfhi(ug.x)));
      r.y = pack2(bflo(ua.y) * sigm(bflo(ug.y)), bfhi(ua.y) * sigm(bfhi(ug.y)));
      r.z = pack2(bflo(ua.z) * sigm(bflo(ug.z)), bfhi(ua.z) * sigm(bfhi(ug.z)));
      r.w = pack2(bflo(ua.w) * sigm(bflo(ug.w)), bfhi(ua.w) * sigm(bfhi(ug.w)));
      *(uint4*)(YG + (size_t)row * 512 + lane * 8) = r;
    }
  }
}

#define QSCALE 0.14724738f
struct EpiQ {
  bf16_t* Q; bf16_t* Qc; const float* rc; const float* rs;
  DEV void operator()(int m, int n, f32x4 v) {
    int head = n / 96, d = n - head * 96;
    if (m < MM) {
      int b = m >> 13, t = m & 8191;
      if (d >= 64) {
        int i0 = (d - 64) >> 1;
        float c0 = rc[t * 16 + i0], s0 = rs[t * 16 + i0], c1 = rc[t * 16 + i0 + 1], s1 = rs[t * 16 + i0 + 1];
        float y0 = v[0] * c0 - v[1] * s0, y1 = v[0] * s0 + v[1] * c0;
        float y2 = v[2] * c1 - v[3] * s1, y3 = v[2] * s1 + v[3] * c1;
        v[0] = y0; v[1] = y1; v[2] = y2; v[3] = y3;
      }
      uint2 r; r.x = pack2(v[0] * QSCALE, v[1] * QSCALE); r.y = pack2(v[2] * QSCALE, v[3] * QSCALE);
      *(uint2*)(Q + ((size_t)(b * 8 + head) * 8192 + t) * 96 + d) = r;
    } else {
      int rr = m - MM; int b = rr >> 8, t = rr & 255;
      uint2 r; r.x = pack2(v[0] * QSCALE, v[1] * QSCALE); r.y = pack2(v[2] * QSCALE, v[3] * QSCALE);
      *(uint2*)(Qc + ((size_t)(b * 8 + head) * 256 + t) * 96 + d) = r;
    }
  }
};
struct EpiKV {
  bf16_t* K; bf16_t* Vt;
  DEV void operator()(int m, int n, f32x4 v) {
    int head = n >> 7, d = n & 127;
    int b, pos;
    if (m < MM) { b = m >> 13; pos = 256 + (m & 8191); } else { int rr = m - MM; b = rr >> 8; pos = rr & 255; }
    if (d < 64) {
      uint2 r; r.x = pack2(v[0], v[1]); r.y = pack2(v[2], v[3]);
      *(uint2*)(K + ((size_t)(b * 8 + head) * 8448 + pos) * 96 + d) = r;
    } else {
      bf16_t* vp = Vt + ((size_t)(b * 8 + head) * 64 + (d - 64)) * 8448 + pos;
      vp[0] = f2bf(v[0]); vp[8448] = f2bf(v[1]); vp[2 * 8448] = f2bf(v[2]); vp[3 * 8448] = f2bf(v[3]);
    }
  }
};

DEV void conv_tile(const Params& p, int tile, char* smem) {
  const bf16_t* YG = WSP(bf16_t, R_YG);
  bf16_t* MIX = WSP(bf16_t, R_MIX);
  const int r0 = tile * 8;
  int seq_start, seq_len;
  if (r0 < MM) { seq_start = (r0 >> 13) << 13; seq_len = 8192; }
  else { int rr = r0 - MM; seq_start = MM + ((rr >> 8) << 8); seq_len = 256; }
  const int t0 = r0 - seq_start;
  const int tid = tidx();
  const int c = tid * 2;
  const int lane = tid & 63, w = tid >> 6;
  bf16_t* stg = (bf16_t*)smem;
  float* ybuf = (float*)(smem + 38 * 1024);
  float* red = ybuf + 8 * 512;
  __syncthreads();
  for (int id = tid; id < 38 * 64; id += 256) {
    const int row = id >> 6, cc = id & 63;
    const int t = t0 - 15 + row;
    uint4 v = make_uint4(0u, 0u, 0u, 0u);
    if (t >= 0 && t < seq_len) v = *(const uint4*)(YG + (size_t)(seq_start + t) * 512 + cc * 8);
    *(uint4*)(stg + row * 512 + cc * 8) = v;
  }
  float w0[31], w1[31];
  const float* cw = p.in[I_CONVW];
#pragma unroll
  for (int i = 0; i < 31; i++) { float2 t = *(const float2*)(cw + i * 512 + c); w0[i] = t.x; w1[i] = t.y; }
  const float2 bb = *(const float2*)(p.in[I_CONVB] + c);
  __syncthreads();
#pragma unroll 1
  for (int i = 0; i < 8; i++) {
    float a0 = bb.x, a1 = bb.y;
#pragma unroll
    for (int wi = 0; wi < 31; wi++) {
      unsigned u = *(const unsigned*)(stg + (i + wi) * 512 + c);
      a0 += bflo(u) * w0[wi]; a1 += bfhi(u) * w1[wi];
    }
    *(float2*)(ybuf + i * 512 + c) = make_float2(a0, a1);
    float s1 = wave_sum(a0 + a1);
    float s2 = wave_sum(a0 * a0 + a1 * a1);
    if (lane == 0) { red[(i * 4 + w) * 2] = s1; red[(i * 4 + w) * 2 + 1] = s2; }
  }
  __syncthreads();
  const float2 lg = *(const float2*)(p.in[I_LNG] + c), lb = *(const float2*)(p.in[I_LNB] + c);
#pragma unroll
  for (int i = 0; i < 8; i++) {
    float S1 = red[i * 8] + red[i * 8 + 2] + red[i * 8 + 4] + red[i * 8 + 6];
    float S2 = red[i * 8 + 1] + red[i * 8 + 3] + red[i * 8 + 5] + red[i * 8 + 7];
    float mean = S1 * (1.f / 512.f);
    float var = fmaxf(S2 * (1.f / 512.f) - mean * mean, 0.f);
    float rinv = rsqrtf(var + 1e-6f);
    float2 y = *(const float2*)(ybuf + i * 512 + c);
    float y0 = (y.x - mean) * rinv * lg.x + lb.x;
    float y1 = (y.y - mean) * rinv * lg.y + lb.y;
    y0 = y0 * sigm(y0); y1 = y1 * sigm(y1);
    *(unsigned*)(MIX + (size_t)(r0 + i) * LDH + 512 + c) = pack2(y0, y1);
  }
}

#define NI_GQ (132 * 6)
#define NI_GKV (132 * 8)
#define NI_CONV (MT / 8)
DEV void phase_qkv_conv(const Params& p, char* smem) {
  EpiQ eq{WSP(bf16_t, R_Q), WSP(bf16_t, R_QC), WSP(float, S_ROPEC), WSP(float, S_ROPES)};
  EpiKV ekv{WSP(bf16_t, R_K), WSP(bf16_t, R_VT)};
  for (int item = blockIdx.x; item < NI_GQ + NI_GKV + NI_CONV; item += gridDim.x) {
    int it = item;
    if (it < NI_GQ) { int mt = it / 6, nt = it - mt * 6; gemm_tile(WSP(bf16_t, R_QN), 256, WSP(bf16_t, S_WUQ), 256, 256, mt * 128, nt * 128, eq, smem); continue; }
    it -= NI_GQ;
    if (it < NI_GKV) { int mt = it >> 3, nt = it & 7; gemm_tile(WSP(bf16_t, R_KVN), 128, WSP(bf16_t, S_WUKV), 128, 128, mt * 128, nt * 128, ekv, smem); continue; }
    it -= NI_GKV;
    conv_tile(p, it, smem);
  }
}

typedef __attribute__((ext_vector_type(16))) float f32x16;
DEV f32x16 mfma32(bf16x8 a, bf16x8 b, f32x16 c) { return __builtin_amdgcn_mfma_f32_32x32x16_bf16(a, b, c, 0, 0, 0); }
#define ASTR 104
#define VSTR 44
DEV void attn_item(const Params& p, int item, char* smem) {
  const int tid = tidx(), lane = tid & 63, w = tid >> 6, c31 = lane & 31, hf = lane >> 5;
  const bf16_t* Qb; int nkeys; size_t out_row0; int bh;
  if (item < 512) {
    const int xcd = item & 7, j = item >> 3;
    bh = xcd * 2 + (j >> 5); int q0 = (j & 31) * 256;
    Qb = WSP(bf16_t, R_Q) + ((size_t)bh * 8192 + q0) * 96; nkeys = 8448; out_row0 = (size_t)(bh >> 3) * 8192 + q0;
  } else {
    bh = item - 512;
    Qb = WSP(bf16_t, R_QC) + ((size_t)bh * 256) * 96; nkeys = 256; out_row0 = (size_t)MM + (bh >> 3) * 256;
  }
  const int h = bh & 7;
  const bf16_t* Kb = WSP(bf16_t, R_K) + (size_t)bh * 8448 * 96;
  const bf16_t* Vb = WSP(bf16_t, R_VT) + (size_t)bh * 64 * 8448;
  bf16_t* Ks = (bf16_t*)smem;
  bf16_t* Vs = Ks + 2 * 32 * ASTR;
  bf16x8 qf[2][6];
#pragma unroll
  for (int jt = 0; jt < 2; jt++)
#pragma unroll
    for (int ks = 0; ks < 6; ks++) qf[jt][ks] = *(const bf16x8*)(Qb + (size_t)(w * 64 + jt * 32 + c31) * 96 + ks * 16 + hf * 8);
  f32x16 o[2][2];
#pragma unroll
  for (int dt = 0; dt < 2; dt++)
#pragma unroll
    for (int jt = 0; jt < 2; jt++)
#pragma unroll
      for (int r = 0; r < 16; r++) o[dt][jt][r] = 0.f;
  float mrun[2] = {-1e30f, -1e30f}, lrun[2] = {0.f, 0.f};
  u32x4 rk0, rk1, rv0;
  const int k0row = tid / 12, k0cc = tid - k0row * 12;
  const int k1id = 256 + (tid & 127), k1row = k1id / 12, k1cc = k1id - k1row * 12;
  const bool has_k1 = tid < 128;
  const int vrow = tid >> 2, vcc = tid & 3;
  const int ntile = nkeys >> 5;
  __syncthreads();
  rk0 = *(const u32x4*)(Kb + (size_t)k0row * 96 + k0cc * 8);
  rk1 = *(const u32x4*)(Kb + (size_t)k1row * 96 + k1cc * 8);
  rv0 = *(const u32x4*)(Vb + (size_t)vrow * 8448 + vcc * 8);
  *(u32x4*)(Ks + k0row * ASTR + k0cc * 8) = rk0;
  if (has_k1) *(u32x4*)(Ks + k1row * ASTR + k1cc * 8) = rk1;
  *(uint2*)(Vs + vrow * VSTR + vcc * 8) = make_uint2(rv0[0], rv0[1]);
  *(uint2*)(Vs + vrow * VSTR + vcc * 8 + 4) = make_uint2(rv0[2], rv0[3]);
  __syncthreads();
  if (ntile > 1) {
    rk0 = *(const u32x4*)(Kb + (size_t)(32 + k0row) * 96 + k0cc * 8);
    rk1 = *(const u32x4*)(Kb + (size_t)(32 + k1row) * 96 + k1cc * 8);
    rv0 = *(const u32x4*)(Vb + (size_t)vrow * 8448 + 32 + vcc * 8);
  }
  for (int kt = 0; kt < ntile; kt++) {
    const bf16_t* Kc = Ks + (kt & 1) * (32 * ASTR);
    const bf16_t* Vc = Vs + (kt & 1) * (64 * VSTR);
    f32x16 s[2];
#pragma unroll
    for (int jt = 0; jt < 2; jt++) {
#pragma unroll
      for (int r = 0; r < 16; r++) s[jt][r] = 0.f;
#pragma unroll
      for (int ks = 0; ks < 6; ks++) {
        bf16x8 kf = *(const bf16x8*)(Kc + c31 * ASTR + ks * 16 + hf * 8);
        s[jt] = mfma32(kf, qf[jt][ks], s[jt]);
      }
    }
#pragma unroll
    for (int jt = 0; jt < 2; jt++) {
      float m0 = fmaxf(fmaxf(s[jt][0], s[jt][1]), fmaxf(s[jt][2], s[jt][3]));
      float m1 = fmaxf(fmaxf(s[jt][4], s[jt][5]), fmaxf(s[jt][6], s[jt][7]));
      float m2 = fmaxf(fmaxf(s[jt][8], s[jt][9]), fmaxf(s[jt][10], s[jt][11]));
      float m3 = fmaxf(fmaxf(s[jt][12], s[jt][13]), fmaxf(s[jt][14], s[jt][15]));
      const float mx = fmaxf(fmaxf(m0, m1), fmaxf(m2, m3));
      if (__any(mx > mrun[jt])) {
        const float mxa = fmaxf(mx, __shfl_xor(mx, 32));
        const float mnew = fmaxf(mrun[jt], mxa);
        const float alpha = __builtin_amdgcn_exp2f(mrun[jt] - mnew);
        mrun[jt] = mnew;
        lrun[jt] *= alpha;
#pragma unroll
        for (int dt = 0; dt < 2; dt++)
#pragma unroll
          for (int r = 0; r < 16; r++) o[dt][jt][r] *= alpha;
      }
      const float mcur = mrun[jt];
      float pv[16];
#pragma unroll
      for (int r = 0; r < 16; r++) pv[r] = __builtin_amdgcn_exp2f(s[jt][r] - mcur);
      lrun[jt] += (((pv[0] + pv[1]) + (pv[2] + pv[3])) + ((pv[4] + pv[5]) + (pv[6] + pv[7]))) +
                  (((pv[8] + pv[9]) + (pv[10] + pv[11])) + ((pv[12] + pv[13]) + (pv[14] + pv[15])));
      bf16x8 pf[2];
#pragma unroll
      for (int ss = 0; ss < 2; ss++) {
        uint4 u; u.x = pack2(pv[8 * ss + 0], pv[8 * ss + 1]); u.y = pack2(pv[8 * ss + 2], pv[8 * ss + 3]);
        u.z = pack2(pv[8 * ss + 4], pv[8 * ss + 5]); u.w = pack2(pv[8 * ss + 6], pv[8 * ss + 7]);
        pf[ss] = __builtin_bit_cast(bf16x8, u);
      }
#pragma unroll
      for (int dt = 0; dt < 2; dt++)
#pragma unroll
        for (int ss = 0; ss < 2; ss++) {
          uint2 lo = *(const uint2*)(Vc + (dt * 32 + c31) * VSTR + 16 * ss + 4 * hf);
          uint2 hi = *(const uint2*)(Vc + (dt * 32 + c31) * VSTR + 16 * ss + 8 + 4 * hf);
          uint4 u; u.x = lo.x; u.y = lo.y; u.z = hi.x; u.w = hi.y;
          o[dt][jt] = mfma32(__builtin_bit_cast(bf16x8, u), pf[ss], o[dt][jt]);
        }
    }
    if (kt + 1 < ntile) {
      bf16_t* Kn = Ks + ((kt + 1) & 1) * (32 * ASTR);
      bf16_t* Vn = Vs + ((kt + 1) & 1) * (64 * VSTR);
      *(u32x4*)(Kn + k0row * ASTR + k0cc * 8) = rk0;
      if (has_k1) *(u32x4*)(Kn + k1row * ASTR + k1cc * 8) = rk1;
      *(uint2*)(Vn + vrow * VSTR + vcc * 8) = make_uint2(rv0[0], rv0[1]);
      *(uint2*)(Vn + vrow * VSTR + vcc * 8 + 4) = make_uint2(rv0[2], rv0[3]);
      __syncthreads();
      if (kt + 2 < ntile) {
        rk0 = *(const u32x4*)(Kb + (size_t)((kt + 2) * 32 + k0row) * 96 + k0cc * 8);
        rk1 = *(const u32x4*)(Kb + (size_t)((kt + 2) * 32 + k1row) * 96 + k1cc * 8);
        rv0 = *(const u32x4*)(Vb + (size_t)vrow * 8448 + (kt + 2) * 32 + vcc * 8);
      }
    }
  }
  bf16_t* MIX = WSP(bf16_t, R_MIX);
#pragma unroll
  for (int jt = 0; jt < 2; jt++) {
    float l = lrun[jt];
    l += __shfl_xor(l, 32);
    const float inv = 1.f / l;
    const size_t row = out_row0 + w * 64 + jt * 32 + c31;
#pragma unroll
    for (int dt = 0; dt < 2; dt++)
#pragma unroll
      for (int g4 = 0; g4 < 4; g4++) {
        uint2 r; r.x = pack2(o[dt][jt][4 * g4 + 0] * inv, o[dt][jt][4 * g4 + 1] * inv); r.y = pack2(o[dt][jt][4 * g4 + 2] * inv, o[dt][jt][4 * g4 + 3] * inv);
        *(uint2*)(MIX + row * LDH + h * 64 + dt * 32 + 8 * g4 + 4 * hf) = r;
      }
  }
}
DEV void phase_attn(const Params& p, char* smem) {
  for (int item = blockIdx.x; item < 512 + 16; item += gridDim.x) attn_item(p, item, smem);
}

struct EpiRes {
  const float* xin_main; const float* xin_ctx; float* X; const float* mod;
  DEV void operator()(int m, int n, f32x4 v) {
    const float* src; int mr;
    if (m < MM) { src = xin_main + (size_t)m * 1024 + n; mr = m >> 13; } else { src = xin_ctx + (size_t)(m - MM) * 1024 + n; mr = 2; }
    float4 xo = *(const float4*)src;
    float4 g = *(const float4*)(mod + (size_t)mr * 6144 + 2048 + n);
    float4 r; r.x = xo.x + g.x * v[0]; r.y = xo.y + g.y * v[1]; r.z = xo.z + g.z * v[2]; r.w = xo.w + g.w * v[3];
    *(float4*)(X + (size_t)m * 1024 + n) = r;
  }
};
DEV void phase_gemm_out(const Params& p, int layer, char* smem) {
  float* X = WSP(float, OFF_X);
  EpiRes epi;
  epi.X = X; epi.mod = WSP(float, S_MOD) + (size_t)layer * 3 * 6144;
  const bf16_t* A; const bf16_t* Bt; int M;
  if (layer == 0) { epi.xin_main = p.in[I_X]; epi.xin_ctx = p.in[I_CTX]; A = WSP(bf16_t, R_MIX); Bt = WSP(bf16_t, S_WOUT0); M = MT; }
  else { epi.xin_main = X; epi.xin_ctx = X + (size_t)MM * 1024; A = WSP(bf16_t, OFF_H); Bt = WSP(bf16_t, S_WHGOUT); M = MM; }
  const int items = xcd_tile_items(M / 128, 8);
  for (int item = blockIdx.x; item < items; item += gridDim.x) {
    int mt, nt;
    if (!xcd_tile(item, M / 128, 8, mt, nt)) continue;
    gemm_tile(A, LDH, Bt, LDH, 1024, mt * 128, nt * 128, epi, smem);
  }
}

struct EpiBf {
  bf16_t* C; int ldc;
  DEV void operator()(int m, int n, f32x4 v) {
    uint2 r; r.x = pack2(v[0], v[1]); r.y = pack2(v[2], v[3]);
    *(uint2*)(C + (size_t)m * ldc + n) = r;
  }
};
DEV void phase_gemm_pq(const Params& p, int layer, int M, char* smem) {
  EpiBf epi{layer ? WSP(bf16_t, L1_PQ) : WSP(bf16_t, R_PQ), 2048};
  const bf16_t* Bt = WSP(bf16_t, S_WPQ) + (size_t)layer * 2048 * LDH;
  const int items = xcd_tile_items(M / 128, 16);
  for (int item = blockIdx.x; item < items; item += gridDim.x) {
    int mt, nt;
    if (!xcd_tile(item, M / 128, 16, mt, nt)) continue;
    gemm_tile(WSP(bf16_t, OFF_H), LDH, Bt, LDH, 1024, mt * 128, nt * 128, epi, smem);
  }
}

DEV void ce(float& a, float& b) { float hi = fmaxf(a, b), lo = fminf(a, b); a = hi; b = lo; }
DEV void bitonic16(float (&l)[16]) {
#pragma unroll
  for (int s = 8; s > 0; s >>= 1)
#pragma unroll
    for (int i = 0; i < 16; i++)
      if (!(i & s)) ce(l[i], l[i + s]);
}
DEV void sort16_desc(float (&a)[16]) {
#pragma unroll
  for (int k = 2; k <= 16; k <<= 1)
#pragma unroll
    for (int j = k >> 1; j > 0; j >>= 1)
#pragma unroll
      for (int i = 0; i < 16; i++) {
        const int p = i ^ j;
        if (p > i) { if ((i & k) == 0) ce(a[i], a[p]); else ce(a[p], a[i]); }
      }
}
DEV void merge_xor(float (&l)[16], int mask) {
  float t[16];
#pragma unroll
  for (int i = 0; i < 16; i++) t[i] = __shfl_xor(l[15 - i], mask);
#pragma unroll
  for (int i = 0; i < 16; i++) l[i] = fmaxf(l[i], t[i]);
  bitonic16(l);
}
DEV void peer_top16(const bf16_t* __restrict__ pq, const bf16_t* sk  , float (&l)[16]) {
  const int lane = tidx() & 63, l15 = lane & 15, quad = lane >> 4;
  f32x4 acc[8];
#pragma unroll
  for (int nt = 0; nt < 8; nt++) acc[nt] = (f32x4){0.f, 0.f, 0.f, 0.f};
#pragma unroll 1
  for (int ks = 0; ks < 4; ks++) {
    const bf16x8 bqk = *(const bf16x8*)(pq + ks * 32 + quad * 8);
#pragma unroll
    for (int nt = 0; nt < 8; nt++) {
      bf16x8 ak = *(const bf16x8*)(sk + (nt * 16 + l15) * 144 + ks * 32 + quad * 8);
      acc[nt] = mfma16(ak, bqk, acc[nt]);
    }
  }
  float hi[16];
#pragma unroll
  for (int nt = 0; nt < 4; nt++)
#pragma unroll
    for (int r = 0; r < 4; r++) {
      l[nt * 4 + r] = __uint_as_float((__float_as_uint(acc[nt][r]) & ~127u) | (unsigned)(nt * 16 + quad * 4 + r));
      hi[nt * 4 + r] = __uint_as_float((__float_as_uint(acc[nt + 4][r]) & ~127u) | (unsigned)((nt + 4) * 16 + quad * 4 + r));
    }
  sort16_desc(l);
  sort16_desc(hi);
#pragma unroll
  for (int i = 0; i < 16; i++) l[i] = fmaxf(l[i], hi[15 - i]);
  bitonic16(l);
  merge_xor(l, 16);
  merge_xor(l, 32);
}
DEV void phase_peer_score(const Params& p, int layer, int M, char* smem) {
  const bf16_t* PQ = layer ? WSP(bf16_t, L1_PQ) : WSP(bf16_t, R_PQ);
  int* EIDX = layer ? WSP(int, L1_EIDX) : WSP(int, R_EIDX);
  float* GATE = layer ? WSP(float, L1_GATE) : WSP(float, R_GATE);
  const bf16_t* SK = WSP(bf16_t, S_SUBK) + (size_t)layer * 16 * 128 * 128;
  const float* USC = WSP(float, S_UVSC) + (size_t)(layer * 2) * 16384;
  const int tid = tidx(), lane = tid & 63, w = tid >> 6, l15 = lane & 15, quad = lane >> 4;
  const int items = (M / 64) * 8;
  bf16_t* SKs = (bf16_t*)smem;
  int hcur = -1;
  for (int item = blockIdx.x; item < items; item += gridDim.x) {
    const int mtile = item >> 3, h = item & 7;
    if (h != hcur) {
      hcur = h;
      __syncthreads();
#pragma unroll
      for (int i = 0; i < 16; i++) {
        int id = tid + i * 256; int row = id >> 4, cc = id & 15;
        *(uint4*)(SKs + row * 144 + cc * 8) = *(const uint4*)(SK + ((size_t)h * 256 + row) * 128 + cc * 8);
      }
      __syncthreads();
    }
    const int m = mtile * 64 + w * 16 + l15;
    float L0[16], L1[16];
    peer_top16(PQ + (size_t)m * 2048 + h * 256, SKs, L0);
    peer_top16(PQ + (size_t)m * 2048 + h * 256 + 128, SKs + 128 * 144, L1);
    float R[16];
#pragma unroll
    for (int i = 0; i < 16; i++) R[i] = -3.0e38f;
#pragma unroll
    for (int i = 0; i < 16; i++)
#pragma unroll
      for (int j = 0; j < 16; j++)
        if ((i + 1) * (j + 1) <= 16) {
          float v = L0[i] + L1[j];
          v = __uint_as_float((__float_as_uint(v) & ~255u) | (unsigned)(i * 16 + j));
#pragma unroll
          for (int t = 0; t < 16; t++)
            if (t >= (i + 1) * (j + 1) - 1) ce(R[t], v);
        }
    unsigned char* tab = (unsigned char*)smem + 73728 + (w * 16 + l15) * 32;
#pragma unroll
    for (int i = 0; i < 16; i++) { tab[i] = (unsigned char)(__float_as_uint(L0[i]) & 127u); tab[16 + i] = (unsigned char)(__float_as_uint(L1[i]) & 127u); }
    float ev[16]; float sum = 0.f;
#pragma unroll
    for (int t = 0; t < 16; t++) { ev[t] = __expf(R[t] - R[0]); sum += ev[t]; }
    const float inv = 1.f / sum;
    int eid[16];
#pragma unroll
    for (int t = 0; t < 16; t++) {
      unsigned code = __float_as_uint(R[t]) & 255u;
      eid[t] = (int)tab[code >> 4] * 128 + (int)tab[16 + (code & 15u)];
    }
    if (quad == 0) {
      int* eo = EIDX + (size_t)m * 128 + h * 16;
      float* go = GATE + (size_t)m * 128 + h * 16;
      float* uo = go + (size_t)MT * 128;
      float us[16], vs[16];
#pragma unroll
      for (int t = 0; t < 16; t++) { us[t] = USC[eid[t]]; vs[t] = USC[16384 + eid[t]]; }
#pragma unroll
      for (int t = 0; t < 16; t += 4) {
        *(int4*)(eo + t) = make_int4(eid[t], eid[t + 1], eid[t + 2], eid[t + 3]);
        *(float4*)(go + t) = make_float4(ev[t] * inv * vs[t], ev[t + 1] * inv * vs[t + 1], ev[t + 2] * inv * vs[t + 2], ev[t + 3] * inv * vs[t + 3]);
        *(float4*)(uo + t) = make_float4(us[t], us[t + 1], us[t + 2], us[t + 3]);
      }
    }
  }
}

DEV f32x2 fp8dot4(unsigned u, f32x2 xa, f32x2 xb, f32x2 d) {
  d += __builtin_amdgcn_cvt_pk_f32_fp8((int)u, false) * xa;
  d += __builtin_amdgcn_cvt_pk_f32_fp8((int)u, true) * xb;
  return d;
}
DEV void phase_peer_expert(const Params& p, int layer, int M, bool final_, int part, char* smem) {
  const bf16_t* H = WSP(bf16_t, OFF_H);
  const int* EIDX = layer ? WSP(int, L1_EIDX) : WSP(int, R_EIDX);
  const float* GATE = layer ? WSP(float, L1_GATE) : WSP(float, R_GATE);
  const float* USEL = GATE + (size_t)MT * 128;
  const unsigned char* U = layer ? WSP(unsigned char, OFF_U1) : WSP(unsigned char, OFF_U0);
  const unsigned char* V = layer ? WSP(unsigned char, OFF_V1) : WSP(unsigned char, OFF_V0);
  float* X = WSP(float, OFF_X);
  float* COEF = layer ? WSP(float, L1_COEF) : WSP(float, R_COEF);
  const float* mod = WSP(float, S_MOD) + (size_t)layer * 3 * 6144;
  const int tid = tidx(), lane = tid & 63, w = tid >> 6, g = lane >> 4, l16 = lane & 15;
  int* se = (int*)smem + w * 512;
  float* sg = (float*)(se + 128);
  float* su = sg + 128;
  float* coefs = su + 128;
  if (part == 0) {
  for (int m = blockIdx.x * 4 + w; m < M; m += gridDim.x * 4) {
    {
      int2 e2 = *(const int2*)(EIDX + (size_t)m * 128 + lane * 2);
      float2 g2 = *(const float2*)(GATE + (size_t)m * 128 + lane * 2);
      float2 u2 = *(const float2*)(USEL + (size_t)m * 128 + lane * 2);
      *(int2*)(se + lane * 2) = e2; *(float2*)(sg + lane * 2) = g2; *(float2*)(su + lane * 2) = u2;
    }
    const bf16_t* hrow = H + (size_t)m * LDH + l16 * 16;
    f32x2 xf[32];
#pragma unroll
    for (int c = 0; c < 4; c++) {
      uint4 a = *(const uint4*)(hrow + c * 256), bq = *(const uint4*)(hrow + c * 256 + 8);
      xf[c * 8 + 0] = (f32x2){bflo(a.x), bfhi(a.x)}; xf[c * 8 + 1] = (f32x2){bflo(a.y), bfhi(a.y)};
      xf[c * 8 + 2] = (f32x2){bflo(a.z), bfhi(a.z)}; xf[c * 8 + 3] = (f32x2){bflo(a.w), bfhi(a.w)};
      xf[c * 8 + 4] = (f32x2){bflo(bq.x), bfhi(bq.x)}; xf[c * 8 + 5] = (f32x2){bflo(bq.y), bfhi(bq.y)};
      xf[c * 8 + 6] = (f32x2){bflo(bq.z), bfhi(bq.z)}; xf[c * 8 + 7] = (f32x2){bflo(bq.w), bfhi(bq.w)};
    }
    __syncthreads();
    u32x4 cur[8], nxt[8];
    {
      const unsigned char* r0p = U + (size_t)se[g] * 1024 + l16 * 16;
      const unsigned char* r1p = U + (size_t)se[4 + g] * 1024 + l16 * 16;
#pragma unroll
      for (int c = 0; c < 4; c++) { cur[c] = *(const u32x4*)(r0p + c * 256); cur[4 + c] = *(const u32x4*)(r1p + c * 256); }
    }
#pragma unroll 2
    for (int st = 0; st < 16; st++) {
      if (st + 1 < 16) {
        const unsigned char* r0p = U + (size_t)se[(st + 1) * 8 + g] * 1024 + l16 * 16;
        const unsigned char* r1p = U + (size_t)se[(st + 1) * 8 + 4 + g] * 1024 + l16 * 16;
#pragma unroll
        for (int c = 0; c < 4; c++) { nxt[c] = *(const u32x4*)(r0p + c * 256); nxt[4 + c] = *(const u32x4*)(r1p + c * 256); }
      }
      f32x2 da = (f32x2){0.f, 0.f}, db = (f32x2){0.f, 0.f};
#pragma unroll
      for (int c = 0; c < 4; c++) {
        da = fp8dot4(cur[c][0], xf[c * 8 + 0], xf[c * 8 + 1], da); da = fp8dot4(cur[c][1], xf[c * 8 + 2], xf[c * 8 + 3], da);
        da = fp8dot4(cur[c][2], xf[c * 8 + 4], xf[c * 8 + 5], da); da = fp8dot4(cur[c][3], xf[c * 8 + 6], xf[c * 8 + 7], da);
        db = fp8dot4(cur[4 + c][0], xf[c * 8 + 0], xf[c * 8 + 1], db); db = fp8dot4(cur[4 + c][1], xf[c * 8 + 2], xf[c * 8 + 3], db);
        db = fp8dot4(cur[4 + c][2], xf[c * 8 + 4], xf[c * 8 + 5], db); db = fp8dot4(cur[4 + c][3], xf[c * 8 + 6], xf[c * 8 + 7], db);
      }
      float d0 = da.x + da.y, d1 = db.x + db.y;
      d0 += __shfl_xor(d0, 1); d1 += __shfl_xor(d1, 1);
      d0 += __shfl_xor(d0, 2); d1 += __shfl_xor(d1, 2);
      d0 += __shfl_xor(d0, 4); d1 += __shfl_xor(d1, 4);
      d0 += __shfl_xor(d0, 8); d1 += __shfl_xor(d1, 8);
      const int s0 = st * 8 + g, s1 = s0 + 4;
      d0 *= su[s0]; d1 *= su[s1];
      const float a0 = 0.5f * d0 * (1.f + erff(d0 * 0.70710678118f));
      const float a1 = 0.5f * d1 * (1.f + erff(d1 * 0.70710678118f));
      if (l16 == 0) { COEF[(size_t)m * 128 + s0] = sg[s0] * a0; COEF[(size_t)m * 128 + s1] = sg[s1] * a1; }
#pragma unroll
      for (int c = 0; c < 8; c++) cur[c] = nxt[c];
    }
    __syncthreads();
  }
  return;
  }
  for (int m = blockIdx.x * 4 + w; m < M; m += gridDim.x * 4) {
    {
      int2 e2 = *(const int2*)(EIDX + (size_t)m * 128 + lane * 2);
      float2 c2 = *(const float2*)(COEF + (size_t)m * 128 + lane * 2);
      *(int2*)(se + lane * 2) = e2; *(float2*)(coefs + lane * 2) = c2;
    }
    u32x4 cur[8], nxt[8];
    __syncthreads();
    f32x2 acc[32];
#pragma unroll
    for (int i = 0; i < 32; i++) acc[i] = (f32x2){0.f, 0.f};
    {
      const unsigned char* r0p = V + (size_t)se[g] * 1024 + l16 * 16;
      const unsigned char* r1p = V + (size_t)se[4 + g] * 1024 + l16 * 16;
#pragma unroll
      for (int c = 0; c < 4; c++) { cur[c] = *(const u32x4*)(r0p + c * 256); cur[4 + c] = *(const u32x4*)(r1p + c * 256); }
    }
#pragma unroll 2
    for (int st = 0; st < 16; st++) {
      if (st + 1 < 16) {
        const unsigned char* r0p = V + (size_t)se[(st + 1) * 8 + g] * 1024 + l16 * 16;
        const unsigned char* r1p = V + (size_t)se[(st + 1) * 8 + 4 + g] * 1024 + l16 * 16;
#pragma unroll
        for (int c = 0; c < 4; c++) { nxt[c] = *(const u32x4*)(r0p + c * 256); nxt[4 + c] = *(const u32x4*)(r1p + c * 256); }
      }
      const float c0 = coefs[st * 8 + g], c1 = coefs[st * 8 + 4 + g];
      const f32x2 ca = (f32x2){c0, c0}, cb = (f32x2){c1, c1};
#pragma unroll
      for (int c = 0; c < 4; c++) {
#pragma unroll
        for (int d = 0; d < 4; d++) {
          acc[c * 8 + d * 2 + 0] += ca * __builtin_amdgcn_cvt_pk_f32_fp8((int)cur[c][d], false);
          acc[c * 8 + d * 2 + 1] += ca * __builtin_amdgcn_cvt_pk_f32_fp8((int)cur[c][d], true);
          acc[c * 8 + d * 2 + 0] += cb * __builtin_amdgcn_cvt_pk_f32_fp8((int)cur[4 + c][d], false);
          acc[c * 8 + d * 2 + 1] += cb * __builtin_amdgcn_cvt_pk_f32_fp8((int)cur[4 + c][d], true);
        }
      }
#pragma unroll
      for (int c = 0; c < 8; c++) cur[c] = nxt[c];
    }
    __syncthreads();
#pragma unroll
    for (int i = 0; i < 32; i++) {
      acc[i].x += __shfl_xor(acc[i].x, 16); acc[i].x += __shfl_xor(acc[i].x, 32);
      acc[i].y += __shfl_xor(acc[i].y, 16); acc[i].y += __shfl_xor(acc[i].y, 32);
    }
    const int mr = (m < MM) ? (m >> 13) : 2;
    const float* m5 = mod + (size_t)mr * 6144 + 5 * 1024;
    float xn[16];
#pragma unroll
    for (int c = 0; c < 4; c++) {
      if (c == g) {
#pragma unroll
        for (int i = 0; i < 8; i++) { xn[2 * i] = acc[c * 8 + i].x; xn[2 * i + 1] = acc[c * 8 + i].y; }
      }
    }
    const int col = g * 256 + l16 * 16;
    float ss = 0.f;
#pragma unroll
    for (int q = 0; q < 4; q++) {
      float4 xa = *(const float4*)(X + (size_t)m * 1024 + col + q * 4);
      float4 ma = *(const float4*)(m5 + col + q * 4);
      xn[q * 4 + 0] = xa.x + ma.x * xn[q * 4 + 0]; xn[q * 4 + 1] = xa.y + ma.y * xn[q * 4 + 1];
      xn[q * 4 + 2] = xa.z + ma.z * xn[q * 4 + 2]; xn[q * 4 + 3] = xa.w + ma.w * xn[q * 4 + 3];
    }
#pragma unroll
    for (int i = 0; i < 16; i++) ss += xn[i] * xn[i];
    if (!final_) {
#pragma unroll
      for (int q = 0; q < 4; q++)
        *(float4*)(X + (size_t)m * 1024 + col + q * 4) = make_float4(xn[q * 4 + 0], xn[q * 4 + 1], xn[q * 4 + 2], xn[q * 4 + 3]);
      ss = wave_sum(ss);
      const float rinv = rsqrtf(ss * (1.f / 1024.f) + 1e-6f);
      const float* ng = p.in[I_N1G] + (layer + 1) * 1024;
      const float* nmod = WSP(float, S_MOD) + (size_t)(layer + 1) * 3 * 6144 + (size_t)mr * 6144;
      unsigned hv[8];
#pragma unroll
      for (int q = 0; q < 4; q++) {
        float4 g4 = *(const float4*)(ng + col + q * 4), sh = *(const float4*)(nmod + col + q * 4), sc = *(const float4*)(nmod + 1024 + col + q * 4);
        hv[q * 2 + 0] = pack2(xn[q * 4 + 0] * rinv * g4.x * (1.f + sc.x) + sh.x, xn[q * 4 + 1] * rinv * g4.y * (1.f + sc.y) + sh.y);
        hv[q * 2 + 1] = pack2(xn[q * 4 + 2] * rinv * g4.z * (1.f + sc.z) + sh.z, xn[q * 4 + 3] * rinv * g4.w * (1.f + sc.w) + sh.w);
      }
      bf16_t* hw = WSP(bf16_t, OFF_H) + (size_t)m * LDH + col;
      *(uint4*)(hw) = make_uint4(hv[0], hv[1], hv[2], hv[3]);
      *(uint4*)(hw + 8) = make_uint4(hv[4], hv[5], hv[6], hv[7]);
    } else {
      ss = wave_sum(ss);
      const float rinv = rsqrtf(ss * (1.f / 1024.f) + 1e-6f);
      const float* fg = p.in[I_FNG];
#pragma unroll
      for (int q = 0; q < 4; q++) {
        float4 g4 = *(const float4*)(fg + col + q * 4);
        *(float4*)(p.out + (size_t)m * 1024 + col + q * 4) = make_float4(xn[q * 4 + 0] * rinv * g4.x, xn[q * 4 + 1] * rinv * g4.y, xn[q * 4 + 2] * rinv * g4.z, xn[q * 4 + 3] * rinv * g4.w);
      }
    }
  }
}

struct EpiHG {
  bf16_t* QH; bf16_t* LF; bf16_t* LB; bf16_t* IH; bf16_t* GH; const float* lbp;
  DEV void operator()(int m, int n, f32x4 v) {
    const int seg = n >> 10, c = n & 1023;
    bf16_t* dst;
    if (seg == 0) dst = QH; else if (seg == 1) dst = LF; else if (seg == 2) dst = LB; else if (seg == 3) dst = IH; else dst = GH;
    if (seg == 1 || seg == 2) {
      const int dir = seg - 1;
#pragma unroll
      for (int r = 0; r < 4; r++) {
        float lb = sigm(lbp[(2 + dir) * 1024 + c + r] - lbp[dir * 1024 + c + r]);
        float ff = lb + (1.f - lb) * sigm(v[r]);
        v[r] = __logf(ff);
      }
    }
    uint2 o; o.x = pack2(v[0], v[1]); o.y = pack2(v[2], v[3]);
    *(uint2*)(dst + (size_t)m * 1024 + c) = o;
  }
};
DEV void phase_gemm_hgin(const Params& p, char* smem) {
  EpiHG epi{WSP(bf16_t, L1_QH), WSP(bf16_t, L1_LF), WSP(bf16_t, L1_LB), WSP(bf16_t, L1_IH), WSP(bf16_t, L1_GH), p.in[I_HGLB]};
  const int items = (MT / 128) * 40;
  for (int item = blockIdx.x; item < items; item += gridDim.x) {
    int mt = item / 40, nt = item - mt * 40;
    gemm_tile(WSP(bf16_t, OFF_H), LDH, WSP(bf16_t, S_WHGIN), LDH, 1024, mt * 128, nt * 128, epi, smem);
  }
}

DEV int hg_row0(int cidx, int b) { return (cidx < 4) ? (MM + b * 256 + cidx * 64) : (b * 8192 + (cidx - 4) * 64); }
DEV int hg_step(int cidx, int dir) {
  if (dir == 0) return cidx;
  return (cidx < 4) ? (3 - cidx) : (4 + 127 - (cidx - 4));
}

DEV void phase_hg_c1(const Params& p, char* smem) {
  const bf16_t* LFp = WSP(bf16_t, L1_LF); const bf16_t* LBp = WSP(bf16_t, L1_LB); const bf16_t* IH = WSP(bf16_t, L1_IH);
  bf16_t* DS = WSP(bf16_t, L1_DS); float* DEC = WSP(float, S_DECAY);
  bf16_t* RA = (bf16_t*)smem;
  bf16_t* RB = RA + 128 * 80;
  bf16_t* Vt = RB + 128 * 80;
  float* tot = (float*)(Vt + 128 * 80);
  const int tid = tidx(), lane = tid & 63, w = tid >> 6, l15 = lane & 15, quad = lane >> 4;
  const int wm = w >> 1, wn = w & 1;
  const int k = tid & 127, half = tid >> 7;
  const int items = 132 * 16;
  for (int item = blockIdx.x; item < items; item += gridDim.x) {
    const int cidx = item >> 4, bh = item & 15, b = bh >> 3, h = bh & 7;
    const int r0 = hg_row0(cidx, b);
    __syncthreads();
#pragma unroll
    for (int i = 0; i < 4; i++) {
      int id = tid + i * 256; int s = id >> 4, cc = id & 15;
      uint4 u = *(const uint4*)(IH + (size_t)(r0 + s) * 1024 + h * 128 + cc * 8);
      uint4 lf = *(const uint4*)(LFp + (size_t)(r0 + s) * 1024 + h * 128 + cc * 8);
      *(uint4*)(RB + s * 144 + cc * 8) = lf;
      bf16_t* vt = Vt + (cc * 8) * 80 + s;
      vt[0] = (bf16_t)(u.x & 0xffff); vt[80] = (bf16_t)(u.x >> 16); vt[160] = (bf16_t)(u.y & 0xffff); vt[240] = (bf16_t)(u.y >> 16);
      vt[320] = (bf16_t)(u.z & 0xffff); vt[400] = (bf16_t)(u.z >> 16); vt[480] = (bf16_t)(u.w & 0xffff); vt[560] = (bf16_t)(u.w >> 16);
    }
#pragma unroll 1
    for (int dir = 0; dir < 2; dir++) {
      bf16_t* stg = dir ? RA : RB;
      bf16_t* kot = dir ? RB : RA;
      if (dir == 1) {
        __syncthreads();
#pragma unroll
        for (int i = 0; i < 4; i++) {
          int id = tid + i * 256; int s = id >> 4, cc = id & 15;
          *(uint4*)(RA + s * 144 + cc * 8) = *(const uint4*)(LBp + (size_t)(r0 + s) * 1024 + h * 128 + cc * 8);
        }
      }
      __syncthreads();
      {
        float t = 0.f;
#pragma unroll 8
        for (int s = 0; s < 32; s++) t += bf2f(stg[(half * 32 + s) * 144 + k]);
        tot[half * 128 + k] = t;
      }
      __syncthreads();
      {
        const float tot0 = tot[k], total = tot0 + tot[128 + k];
        float run = half ? tot0 : 0.f;
        float lfr[32];
#pragma unroll
        for (int s = 0; s < 32; s++) lfr[s] = bf2f(stg[(half * 32 + s) * 144 + k]);
        if (dir == 1) __syncthreads();
        bf16_t* ko = kot + k * 80 + half * 32;
#pragma unroll
        for (int s2 = 0; s2 < 32; s2 += 2) {
          float o2[2];
#pragma unroll
          for (int u = 0; u < 2; u++) {
            const float lf = lfr[s2 + u];
            const float kk = 1.f - __expf(lf);
            float ex;
            if (dir == 0) { run += lf; ex = total - run; } else { ex = run; run += lf; }
            o2[u] = kk * __expf(ex);
          }
          *(unsigned*)(ko + s2) = pack2(o2[0], o2[1]);
        }
        if (half == 0) DEC[((size_t)(bh * 2 + dir) * 132 + hg_step(cidx, dir)) * 128 + k] = __expf(total);
      }
      __syncthreads();
      f32x4 acc[4][4];
#pragma unroll
      for (int i = 0; i < 4; i++)
#pragma unroll
        for (int j = 0; j < 4; j++) acc[i][j] = (f32x4){0.f, 0.f, 0.f, 0.f};
      mfma_lds<4, 4, 2>(kot, 80, Vt, 80, wm * 64, wn * 64, acc);
      bf16_t* dst = DS + ((size_t)(bh * 2 + dir) * 132 + hg_step(cidx, dir)) * 16384;
#pragma unroll
      for (int i = 0; i < 4; i++)
#pragma unroll
        for (int j = 0; j < 4; j++) {
          int kk = wm * 64 + i * 16 + quad * 4, dv = wn * 64 + j * 16 + l15;
          uint2 o; o.x = pack2(acc[i][j][0], acc[i][j][1]); o.y = pack2(acc[i][j][2], acc[i][j][3]);
          *(uint2*)(dst + dv * 128 + kk) = o;
        }
    }
  }
}

DEV void phase_hg_c2(const Params& p) {
  bf16_t* DS = WSP(bf16_t, L1_DS); const float* DEC = WSP(float, S_DECAY);
  for (int idx = blockIdx.x * 256 + tidx(); idx < 32 * 128 * 32; idx += gridDim.x * 256) {
    const int k4 = idx & 31, dv = (idx >> 5) & 127, chain = idx >> 12;
    bf16_t* dp = DS + (size_t)chain * 132 * 16384 + dv * 128 + k4 * 4;
    const float* dc = DEC + (size_t)chain * 132 * 128 + k4 * 4;
    float s0 = 0.f, s1 = 0.f, s2 = 0.f, s3 = 0.f;
    for (int st = 0; st < 132; st += 4) {
      uint2 d[4]; float4 dd[4];
#pragma unroll
      for (int u = 0; u < 4; u++) { d[u] = *(const uint2*)(dp + (size_t)(st + u) * 16384); dd[u] = *(const float4*)(dc + (size_t)(st + u) * 128); }
#pragma unroll
      for (int u = 0; u < 4; u++) {
        uint2 o; o.x = pack2(s0, s1); o.y = pack2(s2, s3);
        *(uint2*)(dp + (size_t)(st + u) * 16384) = o;
        s0 = dd[u].x * s0 + bflo(d[u].x); s1 = dd[u].y * s1 + bfhi(d[u].x);
        s2 = dd[u].z * s2 + bflo(d[u].y); s3 = dd[u].w * s3 + bfhi(d[u].y);
      }
    }
  }
}

DEV void phase_hg_c3(const Params& p, char* smem) {
  const bf16_t* QH = WSP(bf16_t, L1_QH); const bf16_t* LFp = WSP(bf16_t, L1_LF); const bf16_t* LBp = WSP(bf16_t, L1_LB);
  const bf16_t* IH = WSP(bf16_t, L1_IH); const bf16_t* GH = WSP(bf16_t, L1_GH); const bf16_t* DS = WSP(bf16_t, L1_DS);
  bf16_t* Rout = WSP(bf16_t, OFF_H);
  bf16_t* Qin = (bf16_t*)smem;
  bf16_t* Kin = Qin + 64 * 144;
  bf16_t* Vt = Kin + 64 * 144;
  bf16_t* Am = Vt + 128 * 80;
  bf16_t* SpT = Kin;
  float* Ob = (float*)smem;
  float* tot = (float*)(Am);
  const int tid = tidx(), lane = tid & 63, w = tid >> 6, l15 = lane & 15, quad = lane >> 4;
  const int wm = w >> 1, wn = w & 1;
  const int items = 128 * 16;
  for (int item = blockIdx.x; item < items; item += gridDim.x) {
    const int c = item >> 4, bh = item & 15, b = bh >> 3, h = bh & 7;
    const int cidx = c + 4;
    const int r0 = b * 8192 + c * 64;
    f32x4 acc[2][4];
#pragma unroll
    for (int i = 0; i < 2; i++)
#pragma unroll
      for (int j = 0; j < 4; j++) acc[i][j] = (f32x4){0.f, 0.f, 0.f, 0.f};
#pragma unroll 1
    for (int dir = 0; dir < 2; dir++) {
      __syncthreads();
      const int k = tid & 127, half = tid >> 7;
      {
        const bf16_t* lsrc = (dir ? LBp : LFp);
#pragma unroll
        for (int i = 0; i < 4; i++) {
          int id = tid + i * 256; int s = id >> 4, cc = id & 15;
          const size_t go = (size_t)(r0 + s) * 1024 + h * 128 + cc * 8;
          uint4 u = *(const uint4*)(IH + go);
          *(uint4*)(Kin + s * 144 + cc * 8) = *(const uint4*)(lsrc + go);
          *(uint4*)(Qin + s * 144 + cc * 8) = *(const uint4*)(QH + go);
          bf16_t* vt = Vt + (cc * 8) * 80 + s;
          vt[0] = (bf16_t)(u.x & 0xffff); vt[80] = (bf16_t)(u.x >> 16); vt[160] = (bf16_t)(u.y & 0xffff); vt[240] = (bf16_t)(u.y >> 16);
          vt[320] = (bf16_t)(u.z & 0xffff); vt[400] = (bf16_t)(u.z >> 16); vt[480] = (bf16_t)(u.w & 0xffff); vt[560] = (bf16_t)(u.w >> 16);
        }
      }
      u32x4 spr[8];
      {
        const bf16_t* sp = DS + ((size_t)(bh * 2 + dir) * 132 + hg_step(cidx, dir)) * 16384;
#pragma unroll
        for (int i = 0; i < 8; i++) { int id = tid + i * 256; int row = id >> 4, cc = id & 15; spr[i] = *(const u32x4*)(sp + row * 128 + cc * 8); }
      }
      __syncthreads();
      {
        float t = 0.f;
#pragma unroll 8
        for (int s = 0; s < 32; s++) t += bf2f(Kin[(half * 32 + s) * 144 + k]);
        tot[half * 128 + k] = t;
      }
      __syncthreads();
      if (dir == 0) {
        float run = half ? tot[k] : 0.f;
#pragma unroll 4
        for (int s = 0; s < 32; s++) {
          const int t = half * 32 + s;
          const float lf = bf2f(Kin[t * 144 + k]); run += lf;
          const float q = bf2f(Qin[t * 144 + k]);
          Qin[t * 144 + k] = f2bf(q * __expf(run));
          Kin[t * 144 + k] = f2bf((1.f - __expf(lf)) * __expf(-run));
        }
      } else {
        float run = half ? 0.f : tot[128 + k];
#pragma unroll 4
        for (int s = 31; s >= 0; s--) {
          const int t = half * 32 + s;
          const float lf = bf2f(Kin[t * 144 + k]); run += lf;
          const float q = bf2f(Qin[t * 144 + k]);
          Qin[t * 144 + k] = f2bf(q * __expf(run));
          Kin[t * 144 + k] = f2bf((1.f - __expf(lf)) * __expf(-run));
        }
      }
      __syncthreads();
      {
        f32x4 aa[2][2];
#pragma unroll
        for (int i = 0; i < 2; i++) { aa[i][0] = (f32x4){0.f, 0.f, 0.f, 0.f}; aa[i][1] = (f32x4){0.f, 0.f, 0.f, 0.f}; }
        mfma_lds<2, 2, 4>(Qin, 144, Kin, 144, wm * 32, wn * 32, aa);
#pragma unroll
        for (int i = 0; i < 2; i++)
#pragma unroll
          for (int j = 0; j < 2; j++)
#pragma unroll
            for (int r = 0; r < 4; r++) {
              int t = wm * 32 + i * 16 + quad * 4 + r, s = wn * 32 + j * 16 + l15;
              bool keep = dir ? (s >= t) : (s <= t);
              Am[t * 80 + s] = f2bf(keep ? aa[i][j][r] : 0.f);
            }
      }
      __syncthreads();
      mfma_lds<2, 4, 2>(Am, 80, Vt, 80, wm * 32, wn * 64, acc);
      __syncthreads();
#pragma unroll
      for (int i = 0; i < 8; i++) { int id = tid + i * 256; int row = id >> 4, cc = id & 15; *(u32x4*)(SpT + row * 144 + cc * 8) = spr[i]; }
      __syncthreads();
      mfma_lds<2, 4, 4>(Qin, 144, SpT, 144, wm * 32, wn * 64, acc);
    }
    __syncthreads();
#pragma unroll
    for (int i = 0; i < 2; i++)
#pragma unroll
      for (int j = 0; j < 4; j++)
#pragma unroll
        for (int r = 0; r < 4; r++) Ob[(wm * 32 + i * 16 + quad * 4 + r) * 132 + wn * 64 + j * 16 + l15] = acc[i][j][r];
    __syncthreads();
    {
      const int t = tid >> 2, q4 = tid & 3;
      float vals[32]; float ss = 0.f;
#pragma unroll
      for (int j = 0; j < 4; j++) {
        const int dv = (j * 4 + q4) * 8;
        float4 a = *(const float4*)(Ob + t * 132 + dv), bq = *(const float4*)(Ob + t * 132 + dv + 4);
        vals[j * 8 + 0] = a.x; vals[j * 8 + 1] = a.y; vals[j * 8 + 2] = a.z; vals[j * 8 + 3] = a.w;
        vals[j * 8 + 4] = bq.x; vals[j * 8 + 5] = bq.y; vals[j * 8 + 6] = bq.z; vals[j * 8 + 7] = bq.w;
      }
#pragma unroll
      for (int i = 0; i < 32; i++) ss += vals[i] * vals[i];
      ss += __shfl_xor(ss, 1); ss += __shfl_xor(ss, 2);
      const float rinv = rsqrtf(ss * (1.f / 128.f) + 1e-6f);
      const float* ng = p.in[I_HGNG];
#pragma unroll
      for (int j = 0; j < 4; j++) {
        const int col = h * 128 + (j * 4 + q4) * 8;
        uint4 gu = *(const uint4*)(GH + (size_t)(r0 + t) * 1024 + col);
        float4 na = *(const float4*)(ng + col), nb = *(const float4*)(ng + col + 4);
        float g0 = bflo(gu.x), g1 = bfhi(gu.x), g2 = bflo(gu.y), g3 = bfhi(gu.y), g4 = bflo(gu.z), g5 = bfhi(gu.z), g6 = bflo(gu.w), g7 = bfhi(gu.w);
        uint4 o;
        o.x = pack2(vals[j * 8 + 0] * rinv * na.x * g0 * sigm(g0), vals[j * 8 + 1] * rinv * na.y * g1 * sigm(g1));
        o.y = pack2(vals[j * 8 + 2] * rinv * na.z * g2 * sigm(g2), vals[j * 8 + 3] * rinv * na.w * g3 * sigm(g3));
        o.z = pack2(vals[j * 8 + 4] * rinv * nb.x * g4 * sigm(g4), vals[j * 8 + 5] * rinv * nb.y * g5 * sigm(g5));
        o.w = pack2(vals[j * 8 + 6] * rinv * nb.z * g6 * sigm(g6), vals[j * 8 + 7] * rinv * nb.w * g7 * sigm(g7));
        *(uint4*)(Rout + (size_t)(r0 + t) * LDH + col) = o;
      }
    }
  }
}


#define XB_TMO      128
#define XB_XCNT(j)  (256  + 64 * (j))
#define XB_XSUB(j)  (1280 + 64 * (j))
#define XB_XGEN(j)  (2304 + 64 * (j))
#define XB_TOP      3328
#define XB_TOPGEN   3392
#define XCD_BAR_WORDS 3456
#define XB_SPIN_CAP (1u << 22)
#define LAS __attribute__((address_space(3)))
DEV unsigned xb_ld(unsigned* p) { return __hip_atomic_load(p, __ATOMIC_RELAXED, __HIP_MEMORY_SCOPE_AGENT); }
DEV unsigned xb_add(unsigned* p, unsigned v) { return __hip_atomic_fetch_add(p, v, __ATOMIC_RELAXED, __HIP_MEMORY_SCOPE_AGENT); }
DEV unsigned xb_xcc_id() { return (unsigned)__builtin_amdgcn_s_getreg((3 << 11) | 20) & 0xFu; }
#define XB_SPIN(cond, bar) do { unsigned _sp = 0; while (cond) { __builtin_amdgcn_s_sleep(1); \
    if ((++_sp & 255u) == 0u) { if (xb_ld(&(bar)[XB_TMO])) break; if (_sp > XB_SPIN_CAP) { atomicAdd(&(bar)[XB_TMO], 1u); break; } } } } while (0)
struct XcdBarrier { unsigned* bar; unsigned x; volatile LAS unsigned* st; };
DEV XcdBarrier xcd_barrier_post(unsigned* bar, volatile LAS unsigned* st) {
  XcdBarrier b; b.bar = bar; b.x = xb_xcc_id(); b.st = st;
  if (threadIdx.x == 0) (void)xb_add(&bar[XB_XCNT(b.x)], 1u);
  return b;
}
DEV void xcd_barrier_complete(unsigned* bar, unsigned x, unsigned& nloc, unsigned& nx) {
  const unsigned G = gridDim.x * gridDim.y * gridDim.z;
  unsigned sum, cnt, mine, sp = 0u;
  for (;;) {
    sum = 0u; cnt = 0u; mine = 0u;
#pragma unroll
    for (unsigned j = 0; j < 16; ++j) { const unsigned c = xb_ld(&bar[XB_XCNT(j)]); sum += c; cnt += (c > 0u) ? 1u : 0u; mine = (j == x) ? c : mine; }
    if (sum == G) break;
    __builtin_amdgcn_s_sleep(1);
    if ((++sp & 255u) == 0u) { if (xb_ld(&bar[XB_TMO])) break; if (sp > XB_SPIN_CAP) { atomicAdd(&bar[XB_TMO], 1u); break; } }
  }
  nloc = mine > 0u ? mine : 1u; nx = cnt > 0u ? cnt : 1u;
}
DEV void xcd_barrier(const XcdBarrier& b) {
  asm volatile("s_waitcnt vmcnt(0)" ::: "memory");
  __syncthreads();
  if (threadIdx.x == 0) {
    unsigned* bar = b.bar;
    __builtin_amdgcn_s_waitcnt(0);
    unsigned nloc = b.st[0], nx = b.st[1];
    if (nloc == 0u) { xcd_barrier_complete(bar, b.x, nloc, nx); b.st[0] = nloc; b.st[1] = nx; }
    const unsigned old = xb_add(&bar[XB_XSUB(b.x)], 1u);
    const unsigned gen = old / nloc;
    if (old + 1u == (gen + 1u) * nloc) {
      __builtin_amdgcn_fence(__ATOMIC_RELEASE, "agent");
      asm volatile("s_waitcnt vmcnt(0)" ::: "memory");
      const unsigned og = xb_add(&bar[XB_TOP], 1u);
      const unsigned tg = og / nx;
      if (og + 1u == (tg + 1u) * nx) xb_add(&bar[XB_TOPGEN], 1u);
      else XB_SPIN(xb_ld(&bar[XB_TOPGEN]) == tg, bar);
      __builtin_amdgcn_fence(__ATOMIC_ACQUIRE, "agent");
      xb_add(&bar[XB_XGEN(b.x)], 1u);
      asm volatile("s_waitcnt vmcnt(0)" ::: "memory");
    } else {
      XB_SPIN(xb_ld(&bar[XB_XGEN(b.x)]) == gen, bar);
      __builtin_amdgcn_fence(__ATOMIC_ACQUIRE, "agent");
      asm volatile("s_waitcnt vmcnt(0)" ::: "memory");
    }
  }
  __syncthreads();
}

#define NPHASE 21
#define SMEM_BYTES 80896
#define TAB_OFF 80640
DEV void park_params(const Params& p, char* smem) {
  if (tidx() == 0) {
    unsigned long long* tab = (unsigned long long*)(smem + TAB_OFF);
#pragma unroll
    for (int i = 0; i < 27; i++) tab[i] = (unsigned long long)p.in[i];
    tab[27] = (unsigned long long)p.ws;
    tab[28] = (unsigned long long)p.out;
  }
  __syncthreads();
}
DEV unsigned long long tab_get(const char* smem, int i) {
  const unsigned* t = (const unsigned*)(smem + TAB_OFF) + 2 * i;
  unsigned lo = __builtin_amdgcn_readfirstlane(t[0]), hi = __builtin_amdgcn_readfirstlane(t[1]);
  return ((unsigned long long)hi << 32) | lo;
}
typedef __attribute__((address_space(1))) char gchar_t;
DEV void fetch_params(Params& q, const char* smem) {
#pragma unroll
  for (int i = 0; i < 27; i++) q.in[i] = (const float*)(char*)(gchar_t*)tab_get(smem, i);
  q.ws = (char*)(gchar_t*)tab_get(smem, 27);
  q.out = (float*)(char*)(gchar_t*)tab_get(smem, 28);
}
DEV void run_phase(int ph, char* smem) {
#ifdef ONLYPH
  if (ph != ONLYPH) return;
#endif
  Params p;
  fetch_params(p, smem);
  switch (ph) {
    case 0: phase_prep(p, smem); break;
    case 1: phase_norm(p, 0, 0, MT, true); break;
    case 2: phase_gemm_win(p, smem); break;
    case 3: phase_post1(p); break;
    case 4: phase_qkv_conv(p, smem); break;
    case 5: phase_attn(p, smem); break;
    case 6: phase_gemm_out(p, 0, smem); break;
    case 7: phase_norm(p, 0, 1, MT, false); break;
    case 8: phase_gemm_pq(p, 0, MT, smem); break;
    case 9: phase_peer_score(p, 0, MT, smem); break;
    case 10: phase_peer_expert(p, 0, MT, false, 1, smem); break;
    case 110: phase_peer_expert(p, 0, MT, false, 0, smem); break;
    case 11: break;
    case 12: phase_gemm_hgin(p, smem); break;
    case 13: phase_hg_c1(p, smem); break;
    case 14: phase_hg_c2(p); break;
    case 15: phase_hg_c3(p, smem); break;
    case 16: phase_gemm_out(p, 1, smem); break;
    case 17: phase_norm(p, 1, 1, MM, false); break;
    case 18: phase_gemm_pq(p, 1, MM, smem); break;
    case 19: phase_peer_score(p, 1, MM, smem); break;
    case 20: phase_peer_expert(p, 1, MM, true, 1, smem); break;
    case 120: phase_peer_expert(p, 1, MM, true, 0, smem); break;
    default: break;
  }
}

#if MEGA
#define OFF_BAR (492 * MIB)
__global__ void __launch_bounds__(256, 2) fwd_megakernel(Params p) {
  __shared__ __attribute__((aligned(16))) char smem[SMEM_BYTES];
  __shared__ uint4 xb_words;
  cg::grid_group grid = cg::this_grid();
  if (threadIdx.x == 0) xb_words = make_uint4(0u, 0u, 0u, 0u);
  park_params(p, smem);
  XcdBarrier xb = xcd_barrier_post((unsigned*)(p.ws + OFF_BAR), (volatile LAS unsigned*)&xb_words);
#pragma unroll 1
  for (int ph = 0; ph < NPHASE; ph++) {
    if (ph == 11) continue;
    if (ph == 10 || ph == 20) { run_phase(ph + 100, smem); xcd_barrier(xb); }
    run_phase(ph, smem);
    if (ph + 1 < NPHASE) xcd_barrier(xb);
    if (p.ws == nullptr) grid.sync();
  }
}
#else
__global__ void __launch_bounds__(256, 2) fwd_phase(Params p, int ph) {
  __shared__ __attribute__((aligned(16))) char smem[SMEM_BYTES];
  park_params(p, smem);
  run_phase(ph, smem);
}
#endif

extern "C" void kernel_launch(void* const* d_in, const int* in_sizes, int n_in, void* d_out, int out_size, void* d_ws,
                              size_t ws_size, hipStream_t stream) {
  Params p{};
  for (int i = 0; i < 27; i++) p.in[i] = (const float*)d_in[i];
  p.ws = (char*)d_ws;
  p.out = (float*)d_out;
  if (ws_size < WS_NEED) { fprintf(stderr, "workspace too small: %zu\n", ws_size); return; }
#if MEGA
  static int grid_blocks = 0;
  if (!grid_blocks) {
    int dev = 0, cus = 0, per_cu = 0;
    hipGetDevice(&dev);
    hipDeviceGetAttribute(&cus, hipDeviceAttributeMultiprocessorCount, dev);
    hipOccupancyMaxActiveBlocksPerMultiprocessor(&per_cu, fwd_megakernel, 256, 0);
    if (per_cu > 2) per_cu = 2;
    grid_blocks = cus * per_cu;
  }
  hipMemsetAsync((char*)d_ws + OFF_BAR, 0, XCD_BAR_WORDS * 4, stream);
  void* args[] = {&p};
  hipError_t e = hipLaunchCooperativeKernel((void*)fwd_megakernel, dim3(grid_blocks), dim3(256), args, 0, stream);
  if (e != hipSuccess) fprintf(stderr, "cooperative launch failed: %s (grid %d)\n", hipGetErrorString(e), grid_blocks);
#else
  for (int ph = 0; ph < NPHASE; ph++) fwd_phase<<<dim3(1024), dim3(256), 0, stream>>>(p, ph);
#endif
}
```

```cpp
#include <hip/hip_runtime.h>
#include <hip/hip_cooperative_groups.h>
#include <stdint.h>
#include <stdio.h>
namespace cg = cooperative_groups;

#ifndef MEGA
#define MEGA 1
#endif

typedef unsigned short bf16_t;
typedef __attribute__((ext_vector_type(8))) short bf16x8;
typedef __attribute__((ext_vector_type(4))) float f32x4;
typedef __attribute__((ext_vector_type(2))) __bf16 bf2_t;
typedef __attribute__((ext_vector_type(4))) unsigned u32x4;
typedef __attribute__((ext_vector_type(2))) float f32x2;

#define DEV __device__ __forceinline__
#define MM 16384
#define MT 16896
#define MIB ((size_t)1 << 20)

#define OFF_X     ((size_t)0)
#define OFF_H     (66 * MIB)
#define OFF_U1    (103 * MIB)
#define OFF_V1    (131 * MIB)
#define OFF_SMALL (163 * MIB)
#define OFF_U0    (195 * MIB)
#define OFF_V0    (227 * MIB)
#define OFF_R     (259 * MIB)
#define LDH 1088
#define QMIB ((size_t)262144)
#define S_WIN0   (OFF_SMALL)
#define S_WUQ    (OFF_SMALL + 13 * QMIB)
#define S_WUKV   (OFF_SMALL + 13 * QMIB + 393216)
#define S_WOUT0  (OFF_SMALL + 15 * QMIB + 131072)
#define S_WHGIN  (OFF_SMALL + 24 * QMIB)
#define S_WHGOUT (OFF_SMALL + 66 * QMIB + 131072)
#define S_WPQ    (OFF_SMALL + 75 * QMIB)
#define S_SUBK   (OFF_SMALL + 109 * QMIB)
#define S_MOD    (OFF_SMALL + 113 * QMIB)
#define S_ROPEC  (OFF_SMALL + 114 * QMIB)
#define S_ROPES  (OFF_SMALL + 116 * QMIB)
#define S_DECAY  (OFF_SMALL + 118 * QMIB)
#define S_UVSC   (OFF_SMALL + 126 * QMIB + 131072)
#define R_P0   (OFF_R)
#define R_QN   (OFF_R + 50 * MIB)
#define R_KVN  (OFF_R + 59 * MIB)
#define R_YG   (OFF_R + 64 * MIB)
#define R_Q    (OFF_R + 81 * MIB)
#define R_QC   (OFF_R + 105 * MIB)
#define R_K    (OFF_R + 106 * MIB)
#define R_VT   (OFF_R + 131 * MIB)
#define R_MIX  (OFF_R + 148 * MIB)
#define R_EIDX (OFF_R + 184 * MIB)
#define R_GATE (OFF_R + 193 * MIB)
#define R_COEF (OFF_R + 210 * MIB)
#define R_PQ   (OFF_R)
#define L1_QH   (195 * MIB)
#define L1_LF   (228 * MIB)
#define L1_LB   (261 * MIB)
#define L1_IH   (294 * MIB)
#define L1_GH   (327 * MIB)
#define L1_DS   (360 * MIB)
#define L1_PQ   (195 * MIB)
#define L1_EIDX (261 * MIB)
#define L1_GATE (270 * MIB)
#define L1_COEF (287 * MIB)
#define WS_NEED (493 * MIB)

struct Params {
  const float* in[27];
  char* ws;
  float* out;
};
#define WSP(type, off) ((type*)(p.ws + (size_t)(off)))

enum { I_X = 0, I_C, I_CTX, I_CCTX, I_ADAW, I_ADAB, I_N1G, I_N2G, I_WIN, I_QG, I_WUQ, I_KVG, I_WUKV, I_CONVW, I_CONVB,
       I_LNG, I_LNB, I_WOUT, I_HGWIN, I_HGLB, I_HGNG, I_HGWOUT, I_PWQ, I_PSK, I_PU, I_PV, I_FNG };

DEV int tidx() { int t = threadIdx.x; asm volatile("" : "+v"(t)); return t; }
DEV unsigned short f2bf(float x) { return __builtin_bit_cast(unsigned short, (__bf16)x); }
DEV float bf2f(unsigned short b) { return __uint_as_float(((unsigned)b) << 16); }
DEV unsigned pack2(float a, float b) { f32x2 v = {a, b}; return __builtin_bit_cast(unsigned, __builtin_convertvector(v, bf2_t)); }
DEV float bflo(unsigned u) { return __uint_as_float(u << 16); }
DEV float bfhi(unsigned u) { return __uint_as_float(u & 0xffff0000u); }
DEV float wave_sum(float v) {
#pragma unroll
  for (int o = 32; o > 0; o >>= 1) v += __shfl_xor(v, o);
  return v;
}
DEV float sigm(float x) { return 1.f / (1.f + __expf(-x)); }
DEV f32x4 mfma16(bf16x8 a, bf16x8 b, f32x4 c) { return __builtin_amdgcn_mfma_f32_16x16x32_bf16(a, b, c, 0, 0, 0); }
DEV float dot2bf(unsigned a, unsigned b, float c) {
  return __builtin_amdgcn_fdot2_f32_bf16(__builtin_bit_cast(bf2_t, a), __builtin_bit_cast(bf2_t, b), c, false);
}

template <int TI, int TJ, int KS>
DEV void mfma_lds(const bf16_t* Arows, int lda, const bf16_t* Brows, int ldb, int i0, int j0, f32x4 (&acc)[TI][TJ]) {
  const int lane = tidx() & 63, l15 = lane & 15, quad = lane >> 4;
#pragma unroll
  for (int ks = 0; ks < KS; ks++) {
    bf16x8 af[TI], bfr[TJ];
#pragma unroll
    for (int i = 0; i < TI; i++) af[i] = *(const bf16x8*)(Arows + (i0 + i * 16 + l15) * lda + ks * 32 + quad * 8);
#pragma unroll
    for (int j = 0; j < TJ; j++) bfr[j] = *(const bf16x8*)(Brows + (j0 + j * 16 + l15) * ldb + ks * 32 + quad * 8);
#pragma unroll
    for (int i = 0; i < TI; i++)
#pragma unroll
      for (int j = 0; j < TJ; j++) acc[i][j] = mfma16(af[i], bfr[j], acc[i][j]);
  }
}

#define GLD 80
template <class Epi>
DEV void gemm_tile(const bf16_t* __restrict__ A, int lda, const bf16_t* __restrict__ Bt, int ldb, int K, int m0, int n0,
                   Epi& epi, char* smem) {
  bf16_t* As = (bf16_t*)smem;
  bf16_t* Bs = As + 128 * GLD;
  const int tid = tidx(), lane = tid & 63, w = tid >> 6, wm = w >> 1, wn = w & 1;
  const int l15 = lane & 15, quad = lane >> 4;
  f32x4 acc[4][4];
#pragma unroll
  for (int i = 0; i < 4; i++)
#pragma unroll
    for (int j = 0; j < 4; j++) acc[i][j] = (f32x4){0.f, 0.f, 0.f, 0.f};
  u32x4 ra0[4], rb0[4], ra1[4], rb1[4];
  const int nk = K >> 6;
  const int lrow = tid >> 3, lcc = tid & 7;
  const bf16_t* Ap = A + (size_t)(m0 + lrow) * lda + lcc * 8;
  const bf16_t* Bp = Bt + (size_t)(n0 + lrow) * ldb + lcc * 8;
#define G_LOAD(RA, RB, KT) { _Pragma("unroll") for (int i = 0; i < 4; i++) { \
      RA[i] = *(const u32x4*)(Ap + (size_t)(i * 32) * lda + (KT) * 64); RB[i] = *(const u32x4*)(Bp + (size_t)(i * 32) * ldb + (KT) * 64); } }
#define G_STORE(RA, RB) { _Pragma("unroll") for (int i = 0; i < 4; i++) { \
      *(u32x4*)(As + (lrow + i * 32) * GLD + lcc * 8) = RA[i]; *(u32x4*)(Bs + (lrow + i * 32) * GLD + lcc * 8) = RB[i]; } }
  G_LOAD(ra0, rb0, 0);
  G_LOAD(ra1, rb1, 1);
  for (int kt = 0; kt < nk; kt += 2) {
    __syncthreads();
    G_STORE(ra0, rb0);
    __syncthreads();
    if (kt + 2 < nk) G_LOAD(ra0, rb0, kt + 2);
    mfma_lds<4, 4, 2>(Bs, GLD, As, GLD, wn * 64, wm * 64, acc);
    __syncthreads();
    G_STORE(ra1, rb1);
    __syncthreads();
    if (kt + 3 < nk) G_LOAD(ra1, rb1, kt + 3);
    mfma_lds<4, 4, 2>(Bs, GLD, As, GLD, wn * 64, wm * 64, acc);
  }
#undef G_LOAD
#undef G_STORE
#pragma unroll
  for (int i = 0; i < 4; i++)
#pragma unroll
    for (int j = 0; j < 4; j++) epi(m0 + wm * 64 + j * 16 + l15, n0 + wn * 64 + i * 16 + quad * 4, acc[i][j]);
}


DEV bool xcd_tile(int item, int mtiles, int NT, int& mt, int& nt) {
  const int nng = NT >> 3;
  const int xcd = item & 7, j = item >> 3;
  const int group = (j >> 6) * 8 + xcd, within = j & 63;
  const int mg = group / nng, ng = group - mg * nng;
  mt = mg * 8 + (within >> 3); nt = ng * 8 + (within & 7);
  return mt < mtiles;
}
DEV int xcd_tile_items(int mtiles, int NT) { const int groups = ((mtiles + 7) >> 3) * (NT >> 3); return ((groups + 7) >> 3) * 8 * 64; }

DEV void transpose_tile(const float* __restrict__ W, int K, int N, bf16_t* __restrict__ Wt, int ldt, int tile, char* smem) {
  float* sm = (float*)smem;
  const int ntn = N >> 5;
  const int kt = tile / ntn, nt = tile - kt * ntn;
  const int tx = tidx() & 31, ty = tidx() >> 5;
  __syncthreads();
#pragma unroll
  for (int i = 0; i < 4; i++) { int k = ty + i * 8; sm[k * 33 + tx] = W[(size_t)(kt * 32 + k) * N + nt * 32 + tx]; }
  __syncthreads();
#pragma unroll
  for (int i = 0; i < 4; i++) { int n = ty + i * 8; Wt[(size_t)(nt * 32 + n) * ldt + kt * 32 + tx] = f2bf(sm[tx * 33 + n]); }
}
DEV void convert_chunk(const float* __restrict__ src, bf16_t* __restrict__ dst, int chunk) {
  size_t o = (size_t)chunk * 2048 + tidx() * 8;
  float4 a = *(const float4*)(src + o), b = *(const float4*)(src + o + 4);
  uint4 r; r.x = pack2(a.x, a.y); r.y = pack2(a.z, a.w); r.z = pack2(b.x, b.y); r.w = pack2(b.z, b.w);
  *(uint4*)(dst + o) = r;
}

#define NT_WIN   1440
#define NT_WUQ   192
#define NT_WUKV  128
#define NT_WOUT  1024
#define NT_HGIN  5120
#define NT_HGOUT 1024
#define NT_WPQ   4096
#define P0_TR (NT_WIN + NT_WUQ + NT_WUKV + NT_WOUT + NT_HGIN + NT_HGOUT + NT_WPQ)
#define P0_CV_SUBK 256
#define P0_CV_U 2048
#define P0_CV_V 2048
#define P0_ZP 51
#define P0_MOD 384
#define P0_ROPE 512
#define P0_ITEMS (P0_TR + P0_CV_SUBK + P0_CV_U + P0_CV_V + P0_ZP + P0_MOD + P0_ROPE)

DEV void phase_prep(const Params& p, char* smem) {
  for (int item = blockIdx.x; item < P0_ITEMS; item += gridDim.x) {
    int it = item;
    if (it < P0_TR) {
      if (it < NT_WIN) { transpose_tile(p.in[I_WIN], 1024, 1440, WSP(bf16_t, S_WIN0), LDH, it, smem); continue; }
      it -= NT_WIN;
      if (it < NT_WUQ) { transpose_tile(p.in[I_WUQ], 256, 768, WSP(bf16_t, S_WUQ), 256, it, smem); continue; }
      it -= NT_WUQ;
      if (it < NT_WUKV) { transpose_tile(p.in[I_WUKV], 128, 1024, WSP(bf16_t, S_WUKV), 128, it, smem); continue; }
      it -= NT_WUKV;
      if (it < NT_WOUT) { transpose_tile(p.in[I_WOUT], 1024, 1024, WSP(bf16_t, S_WOUT0), LDH, it, smem); continue; }
      it -= NT_WOUT;
      if (it < NT_HGIN) { transpose_tile(p.in[I_HGWIN], 1024, 5120, WSP(bf16_t, S_WHGIN), LDH, it, smem); continue; }
      it -= NT_HGIN;
      if (it < NT_HGOUT) { transpose_tile(p.in[I_HGWOUT], 1024, 1024, WSP(bf16_t, S_WHGOUT), LDH, it, smem); continue; }
      it -= NT_HGOUT;
      int l = it >> 11; it &= 2047;
      transpose_tile(p.in[I_PWQ] + (size_t)l * 1024 * 2048, 1024, 2048, WSP(bf16_t, S_WPQ) + (size_t)l * 2048 * LDH, LDH, it, smem);
      continue;
    }
    it -= P0_TR;
    if (it < P0_CV_SUBK) { convert_chunk(p.in[I_PSK], WSP(bf16_t, S_SUBK), it); continue; }
    it -= P0_CV_SUBK;
    if (it < P0_CV_U + P0_CV_V) {
      const int isv = it >= P0_CV_U; const int r16 = isv ? it - P0_CV_U : it;
      const int lane = tidx() & 63;
      const int rowb = r16 * 16 + (tidx() >> 6) * 4;
      const float* src = (isv ? p.in[I_PV] : p.in[I_PU]) + (size_t)rowb * 1024 + lane * 16;
      float4 v[4][4];
#pragma unroll
      for (int r = 0; r < 4; r++)
#pragma unroll
        for (int q = 0; q < 4; q++) v[r][q] = *(const float4*)(src + (size_t)r * 1024 + q * 4);
#pragma unroll
      for (int r = 0; r < 4; r++) {
        float mx = 0.f;
#pragma unroll
        for (int q = 0; q < 4; q++) mx = fmaxf(mx, fmaxf(fmaxf(fabsf(v[r][q].x), fabsf(v[r][q].y)), fmaxf(fabsf(v[r][q].z), fabsf(v[r][q].w))));
#pragma unroll
        for (int o = 32; o > 0; o >>= 1) mx = fmaxf(mx, __shfl_xor(mx, o));
        mx = fmaxf(mx, 1e-30f);
        const float sc = exp2f(floorf(log2f(384.f / mx)));
        unsigned ow[4];
#pragma unroll
        for (int q = 0; q < 4; q++) {
          int t = __builtin_amdgcn_cvt_pk_fp8_f32(v[r][q].x * sc, v[r][q].y * sc, 0, false);
          t = __builtin_amdgcn_cvt_pk_fp8_f32(v[r][q].z * sc, v[r][q].w * sc, t, true);
          ow[q] = (unsigned)t;
        }
        const int row = rowb + r; const int l = row >> 14, e = row & 16383;
        unsigned char* dst = isv ? (l ? WSP(unsigned char, OFF_V1) : WSP(unsigned char, OFF_V0)) : (l ? WSP(unsigned char, OFF_U1) : WSP(unsigned char, OFF_U0));
        *(uint4*)(dst + (size_t)e * 1024 + lane * 16) = make_uint4(ow[0], ow[1], ow[2], ow[3]);
        if (lane == 0) WSP(float, S_UVSC)[(l * 2 + isv) * 16384 + e] = 1.f / sc;
      }
      continue;
    }
    it -= P0_CV_U;
    it -= P0_CV_V;
    if (it < P0_ZP) {
      bf16_t* dst = WSP(bf16_t, S_WIN0) + (size_t)1440 * LDH + (size_t)it * 2048 + tidx() * 8;
      *(uint4*)dst = make_uint4(0u, 0u, 0u, 0u);
      continue;
    }
    it -= P0_ZP;
    if (it < P0_MOD) {
      const int l = it / 192, nb = it - l * 192;
      const int col = tidx() & 31, kg = tidx() >> 5;
      const int n = nb * 32 + col;
      const float* W = p.in[I_ADAW] + (size_t)l * 1024 * 6144;
      float* sv = (float*)smem;
      float* red = sv + 3072;
      __syncthreads();
      for (int i = tidx(); i < 3072; i += 256) {
        const int r = i >> 10, k = i & 1023;
        const float c = (r < 2) ? p.in[I_C][r * 1024 + k] : p.in[I_CCTX][k];
        sv[i] = c * sigm(c);
      }
      __syncthreads();
      float a0 = 0.f, a1 = 0.f, a2 = 0.f;
      const float* wp = W + (size_t)(kg * 128) * 6144 + n;
#pragma unroll 1
      for (int kb = 0; kb < 128; kb += 32) {
        float wv[32];
#pragma unroll
        for (int u = 0; u < 32; u++) wv[u] = wp[(size_t)(kb + u) * 6144];
#pragma unroll
        for (int u = 0; u < 32; u++) {
          const int k = kg * 128 + kb + u;
          a0 += sv[k] * wv[u]; a1 += sv[1024 + k] * wv[u]; a2 += sv[2048 + k] * wv[u];
        }
      }
      red[(kg * 32 + col) * 3 + 0] = a0; red[(kg * 32 + col) * 3 + 1] = a1; red[(kg * 32 + col) * 3 + 2] = a2;
      __syncthreads();
      if (tidx() < 96) {
        int r = tidx() >> 5, cc = tidx() & 31;
        float sum = 0.f;
        for (int g = 0; g < 8; g++) sum += red[(g * 32 + cc) * 3 + r];
        int nn = nb * 32 + cc;
        WSP(float, S_MOD)[(size_t)(l * 3 + r) * 6144 + nn] = sum + p.in[I_ADAB][l * 6144 + nn];
      }
      continue;
    }
    it -= P0_MOD;
    {
      int idx = it * 256 + tidx();
      int t = idx >> 4, i = idx & 15;
      int f = i & 7;
      float pos = (i < 8) ? (float)(t >> 6) : (float)(t & 63);
      float inv = powf(10000.f, -(float)(2 * f) / 16.f);
      float ang = pos * inv;
      WSP(float, S_ROPEC)[idx] = cosf(ang);
      WSP(float, S_ROPES)[idx] = sinf(ang);
    }
  }
}

DEV void phase_norm(const Params& p, int layer, int which, int M, bool from_inputs) {
  const float* g = p.in[which ? I_N2G : I_N1G] + layer * 1024;
  const float* mod = WSP(float, S_MOD) + (size_t)layer * 3 * 6144;
  const int shift_c = which ? 3 : 0, scale_c = which ? 4 : 1;
  const float* X = WSP(float, OFF_X);
  bf16_t* H = WSP(bf16_t, OFF_H);
  const int wave = tidx() >> 6, lane = tidx() & 63;
  for (int row = blockIdx.x * 4 + wave; row < M; row += gridDim.x * 4) {
    const float* src; int mr;
    if (row < MM) { src = (from_inputs ? p.in[I_X] : X) + (size_t)row * 1024; mr = row >> 13; }
    else { src = from_inputs ? (p.in[I_CTX] + (size_t)(row - MM) * 1024) : (X + (size_t)row * 1024); mr = 2; }
    float4 v[4]; float ss = 0.f;
#pragma unroll
    for (int i = 0; i < 4; i++) {
      v[i] = ((const float4*)src)[lane + i * 64];
      ss += v[i].x * v[i].x + v[i].y * v[i].y + v[i].z * v[i].z + v[i].w * v[i].w;
    }
    ss = wave_sum(ss);
    const float rinv = rsqrtf(ss * (1.f / 1024.f) + 1e-6f);
    const float* msh = mod + (size_t)mr * 6144 + shift_c * 1024;
    const float* msc = mod + (size_t)mr * 6144 + scale_c * 1024;
#pragma unroll
    for (int i = 0; i < 4; i++) {
      int c4 = lane + i * 64;
      float4 g4 = ((const float4*)g)[c4], sh = ((const float4*)msh)[c4], sc = ((const float4*)msc)[c4];
      float o0 = v[i].x * rinv * g4.x * (1.f + sc.x) + sh.x;
      float o1 = v[i].y * rinv * g4.y * (1.f + sc.y) + sh.y;
      float o2 = v[i].z * rinv * g4.z * (1.f + sc.z) + sh.z;
      float o3 = v[i].w * rinv * g4.w * (1.f + sc.w) + sh.w;
      uint2 r; r.x = pack2(o0, o1); r.y = pack2(o2, o3);
      *(uint2*)(H + (size_t)row * LDH + c4 * 4) = r;
    }
  }
}

struct EpiP0 {
  bf16_t* P0;
  DEV void operator()(int m, int n, f32x4 v) {
    if (n < 1440) { uint2 r; r.x = pack2(v[0], v[1]); r.y = pack2(v[2], v[3]); *(uint2*)(P0 + (size_t)m * 1536 + n) = r; }
  }
};
DEV void phase_gemm_win(const Params& p, char* smem) {
  EpiP0 epi{WSP(bf16_t, R_P0)};
  const int NTL = 12, items = (MT / 128) * NTL;
  for (int item = blockIdx.x; item < items; item += gridDim.x) {
    int mt = item / NTL, nt = item - mt * NTL;
    gemm_tile(WSP(bf16_t, OFF_H), LDH, WSP(bf16_t, S_WIN0), LDH, 1024, mt * 128, nt * 128, epi, smem);
  }
}

DEV void phase_post1(const Params& p) {
  const bf16_t* P0 = WSP(bf16_t, R_P0);
  bf16_t* QN = WSP(bf16_t, R_QN); bf16_t* KVN = WSP(bf16_t, R_KVN); bf16_t* YG = WSP(bf16_t, R_YG);
  bf16_t* Kb = WSP(bf16_t, R_K);
  const float* rc = WSP(float, S_ROPEC); const float* rs = WSP(float, S_ROPES);
  const float* qg = p.in[I_QG]; const float* kvg = p.in[I_KVG];
  const int wave = tidx() >> 6, lane = tidx() & 63;
  for (int row = blockIdx.x * 4 + wave; row < MT; row += gridDim.x * 4) {
    const bf16_t* pr = P0 + (size_t)row * 1536;
    {
      uint2 u = *(const uint2*)(pr + lane * 4);
      float a0 = bflo(u.x), a1 = bfhi(u.x), a2 = bflo(u.y), a3 = bfhi(u.y);
      float ss = wave_sum(a0 * a0 + a1 * a1 + a2 * a2 + a3 * a3);
      float rinv = rsqrtf(ss * (1.f / 256.f) + 1e-6f);
      float4 g4 = ((const float4*)qg)[lane];
      uint2 r; r.x = pack2(a0 * rinv * g4.x, a1 * rinv * g4.y); r.y = pack2(a2 * rinv * g4.z, a3 * rinv * g4.w);
      *(uint2*)(QN + (size_t)row * 256 + lane * 4) = r;
    }
    {
      unsigned u = *(const unsigned*)(pr + 256 + lane * 2);
      float a0 = bflo(u), a1 = bfhi(u);
      float ss = wave_sum(a0 * a0 + a1 * a1);
      float rinv = rsqrtf(ss * (1.f / 128.f) + 1e-6f);
      float2 g2 = ((const float2*)kvg)[lane];
      *(unsigned*)(KVN + (size_t)row * 128 + lane * 2) = pack2(a0 * rinv * g2.x, a1 * rinv * g2.y);
    }
    if (lane < 16) {
      unsigned u = *(const unsigned*)(pr + 384 + lane * 2);
      float x0 = bflo(u), x1 = bfhi(u);
      int b, pos;
      if (row < MM) {
        b = row >> 13; int t = row & 8191; pos = 256 + t;
        float c = rc[t * 16 + lane], s = rs[t * 16 + lane];
        float y0 = x0 * c - x1 * s, y1 = x0 * s + x1 * c; x0 = y0; x1 = y1;
      } else { int rr = row - MM; b = rr >> 8; pos = rr & 255; }
      unsigned o = pack2(x0, x1);
#pragma unroll
      for (int h = 0; h < 8; h++) *(unsigned*)(Kb + ((size_t)(b * 8 + h) * 8448 + pos) * 96 + 64 + lane * 2) = o;
    }
    {
      uint4 ua = *(const uint4*)(pr + 416 + lane * 8);
      uint4 ug = *(const uint4*)(pr + 416 + 512 + lane * 8);
      uint4 r;
      r.x = pack2(bflo(ua.x) * sigm(bflo(ug.x)), bfhi(ua.x) * sigm(bfhi(ug.x)));
      r.y = pack2(bflo(ua.y) * sigm(bflo(ug.y)), bfhi(ua.y) * sigm(bfhi(ug.y)));
      r.z = pack2(bflo(ua.z) * sigm(bflo(ug.z)), bfhi(ua.z) * sigm(bfhi(ug.z)));
      r.w = pack2(bflo(ua.w) * sigm(bflo(ug.w)), bfhi(ua.w) * sigm(bfhi(ug.w)));
      *(uint4*)(YG + (size_t)row * 512 + lane * 8) = r;
    }
  }
}

#define QSCALE 0.14724738f
struct EpiQ {
  bf16_t* Q; bf16_t* Qc; const float* rc; const float* rs;
  DEV void operator()(int m, int n, f32x4 v) {
    int head = n / 96, d = n - head * 96;
    if (m < MM) {
      int b = m >> 13, t = m & 8191;
      if (d >= 64) {
        int i0 = (d - 64) >> 1;
        float c0 = rc[t * 16 + i0], s0 = rs[t * 16 + i0], c1 = rc[t * 16 + i0 + 1], s1 = rs[t * 16 + i0 + 1];
        float y0 = v[0] * c0 - v[1] * s0, y1 = v[0] * s0 + v[1] * c0;
        float y2 = v[2] * c1 - v[3] * s1, y3 = v[2] * s1 + v[3] * c1;
        v[0] = y0; v[1] = y1; v[2] = y2; v[3] = y3;
      }
      uint2 r; r.x = pack2(v[0] * QSCALE, v[1] * QSCALE); r.y = pack2(v[2] * QSCALE, v[3] * QSCALE);
      *(uint2*)(Q + ((size_t)(b * 8 + head) * 8192 + t) * 96 + d) = r;
    } else {
      int rr = m - MM; int b = rr >> 8, t = rr & 255;
      uint2 r; r.x = pack2(v[0] * QSCALE, v[1] * QSCALE); r.y = pack2(v[2] * QSCALE, v[3] * QSCALE);
      *(uint2*)(Qc + ((size_t)(b * 8 + head) * 256 + t) * 96 + d) = r;
    }
  }
};
struct EpiKV {
  bf16_t* K; bf16_t* Vt;
  DEV void operator()(int m, int n, f32x4 v) {
    int head = n >> 7, d = n & 127;
    int b, pos;
    if (m < MM) { b = m >> 13; pos = 256 + (m & 8191); } else { int rr = m - MM; b = rr >> 8; pos = rr & 255; }
    if (d < 64) {
      uint2 r; r.x = pack2(v[0], v[1]); r.y = pack2(v[2], v[3]);
      *(uint2*)(K + ((size_t)(b * 8 + head) * 8448 + pos) * 96 + d) = r;
    } else {
      bf16_t* vp = Vt + ((size_t)(b * 8 + head) * 64 + (d - 64)) * 8448 + pos;
      vp[0] = f2bf(v[0]); vp[8448] = f2bf(v[1]); vp[2 * 8448] = f2bf(v[2]); vp[3 * 8448] = f2bf(v[3]);
    }
  }
};

DEV void conv_tile(const Params& p, int tile, char* smem) {
  const bf16_t* YG = WSP(bf16_t, R_YG);
  bf16_t* MIX = WSP(bf16_t, R_MIX);
  const int r0 = tile * 8;
  int seq_start, seq_len;
  if (r0 < MM) { seq_start = (r0 >> 13) << 13; seq_len = 8192; }
  else { int rr = r0 - MM; seq_start = MM + ((rr >> 8) << 8); seq_len = 256; }
  const int t0 = r0 - seq_start;
  const int tid = tidx();
  const int c = tid * 2;
  const int lane = tid & 63, w = tid >> 6;
  bf16_t* stg = (bf16_t*)smem;
  float* ybuf = (float*)(smem + 38 * 1024);
  float* red = ybuf + 8 * 512;
  __syncthreads();
  for (int id = tid; id < 38 * 64; id += 256) {
    const int row = id >> 6, cc = id & 63;
    const int t = t0 - 15 + row;
    uint4 v = make_uint4(0u, 0u, 0u, 0u);
    if (t >= 0 && t < seq_len) v = *(const uint4*)(YG + (size_t)(seq_start + t) * 512 + cc * 8);
    *(uint4*)(stg + row * 512 + cc * 8) = v;
  }
  float w0[31], w1[31];
  const float* cw = p.in[I_CONVW];
#pragma unroll
  for (int i = 0; i < 31; i++) { float2 t = *(const float2*)(cw + i * 512 + c); w0[i] = t.x; w1[i] = t.y; }
  const float2 bb = *(const float2*)(p.in[I_CONVB] + c);
  __syncthreads();
#pragma unroll 1
  for (int i = 0; i < 8; i++) {
    float a0 = bb.x, a1 = bb.y;
#pragma unroll
    for (int wi = 0; wi < 31; wi++) {
      unsigned u = *(const unsigned*)(stg + (i + wi) * 512 + c);
      a0 += bflo(u) * w0[wi]; a1 += bfhi(u) * w1[wi];
    }
    *(float2*)(ybuf + i * 512 + c) = make_float2(a0, a1);
    float s1 = wave_sum(a0 + a1);
    float s2 = wave_sum(a0 * a0 + a1 * a1);
    if (lane == 0) { red[(i * 4 + w) * 2] = s1; red[(i * 4 + w) * 2 + 1] = s2; }
  }
  __syncthreads();
  const float2 lg = *(const float2*)(p.in[I_LNG] + c), lb = *(const float2*)(p.in[I_LNB] + c);
#pragma unroll
  for (int i = 0; i < 8; i++) {
    float S1 = red[i * 8] + red[i * 8 + 2] + red[i * 8 + 4] + red[i * 8 + 6];
    float S2 = red[i * 8 + 1] + red[i * 8 + 3] + red[i * 8 + 5] + red[i * 8 + 7];
    float mean = S1 * (1.f / 512.f);
    float var = fmaxf(S2 * (1.f / 512.f) - mean * mean, 0.f);
    float rinv = rsqrtf(var + 1e-6f);
    float2 y = *(const float2*)(ybuf + i * 512 + c);
    float y0 = (y.x - mean) * rinv * lg.x + lb.x;
    float y1 = (y.y - mean) * rinv * lg.y + lb.y;
    y0 = y0 * sigm(y0); y1 = y1 * sigm(y1);
    *(unsigned*)(MIX + (size_t)(r0 + i) * LDH + 512 + c) = pack2(y0, y1);
  }
}

#define NI_GQ (132 * 6)
#define NI_GKV (132 * 8)
#define NI_CONV (MT / 8)
DEV void phase_qkv_conv(const Params& p, char* smem) {
  EpiQ eq{WSP(bf16_t, R_Q), WSP(bf16_t, R_QC), WSP(float, S_ROPEC), WSP(float, S_ROPES)};
  EpiKV ekv{WSP(bf16_t, R_K), WSP(bf16_t, R_VT)};
  for (int item = blockIdx.x; item < NI_GQ + NI_GKV + NI_CONV; item += gridDim.x) {
    int it = item;
    if (it < NI_GQ) { int mt = it / 6, nt = it - mt * 6; gemm_tile(WSP(bf16_t, R_QN), 256, WSP(bf16_t, S_WUQ), 256, 256, mt * 128, nt * 128, eq, smem); continue; }
    it -= NI_GQ;
    if (it < NI_GKV) { int mt = it >> 3, nt = it & 7; gemm_tile(WSP(bf16_t, R_KVN), 128, WSP(bf16_t, S_WUKV), 128, 128, mt * 128, nt * 128, ekv, smem); continue; }
    it -= NI_GKV;
    conv_tile(p, (it & 7) * (NI_CONV / 8) + (it >> 3), smem);
  }
}

typedef __attribute__((ext_vector_type(16))) float f32x16;
DEV f32x16 mfma32(bf16x8 a, bf16x8 b, f32x16 c) { return __builtin_amdgcn_mfma_f32_32x32x16_bf16(a, b, c, 0, 0, 0); }
#define ASTR 104
#define VSTR 44
DEV void attn_item(const Params& p, int item, char* smem) {
  const int tid = tidx(), lane = tid & 63, w = tid >> 6, c31 = lane & 31, hf = lane >> 5;
  const bf16_t* Qb; int nkeys; size_t out_row0; int bh;
  if (item < 512) {
    const int xcd = item & 7, j = item >> 3;
    bh = xcd * 2 + (j >> 5); int q0 = (j & 31) * 256;
    Qb = WSP(bf16_t, R_Q) + ((size_t)bh * 8192 + q0) * 96; nkeys = 8448; out_row0 = (size_t)(bh >> 3) * 8192 + q0;
  } else {
    bh = item - 512;
    Qb = WSP(bf16_t, R_QC) + ((size_t)bh * 256) * 96; nkeys = 256; out_row0 = (size_t)MM + (bh >> 3) * 256;
  }
  const int h = bh & 7;
  const bf16_t* Kb = WSP(bf16_t, R_K) + (size_t)bh * 8448 * 96;
  const bf16_t* Vb = WSP(bf16_t, R_VT) + (size_t)bh * 64 * 8448;
  bf16_t* Ks = (bf16_t*)smem;
  bf16_t* Vs = Ks + 2 * 32 * ASTR;
  bf16x8 qf[2][6];
#pragma unroll
  for (int jt = 0; jt < 2; jt++)
#pragma unroll
    for (int ks = 0; ks < 6; ks++) qf[jt][ks] = *(const bf16x8*)(Qb + (size_t)(w * 64 + jt * 32 + c31) * 96 + ks * 16 + hf * 8);
  f32x16 o[2][2];
#pragma unroll
  for (int dt = 0; dt < 2; dt++)
#pragma unroll
    for (int jt = 0; jt < 2; jt++)
#pragma unroll
      for (int r = 0; r < 16; r++) o[dt][jt][r] = 0.f;
  float mrun[2] = {-1e30f, -1e30f}, lrun[2] = {0.f, 0.f};
  u32x4 rk0, rk1, rv0;
  const int k0row = tid / 12, k0cc = tid - k0row * 12;
  const int k1id = 256 + (tid & 127), k1row = k1id / 12, k1cc = k1id - k1row * 12;
  const bool has_k1 = tid < 128;
  const int vrow = tid >> 2, vcc = tid & 3;
  const int ntile = nkeys >> 5;
  __syncthreads();
  rk0 = *(const u32x4*)(Kb + (size_t)k0row * 96 + k0cc * 8);
  rk1 = *(const u32x4*)(Kb + (size_t)k1row * 96 + k1cc * 8);
  rv0 = *(const u32x4*)(Vb + (size_t)vrow * 8448 + vcc * 8);
  *(u32x4*)(Ks + k0row * ASTR + k0cc * 8) = rk0;
  if (has_k1) *(u32x4*)(Ks + k1row * ASTR + k1cc * 8) = rk1;
  *(uint2*)(Vs + vrow * VSTR + vcc * 8) = make_uint2(rv0[0], rv0[1]);
  *(uint2*)(Vs + vrow * VSTR + vcc * 8 + 4) = make_uint2(rv0[2], rv0[3]);
  __syncthreads();
  if (ntile > 1) {
    rk0 = *(const u32x4*)(Kb + (size_t)(32 + k0row) * 96 + k0cc * 8);
    rk1 = *(const u32x4*)(Kb + (size_t)(32 + k1row) * 96 + k1cc * 8);
    rv0 = *(const u32x4*)(Vb + (size_t)vrow * 8448 + 32 + vcc * 8);
  }
  for (int kt = 0; kt < ntile; kt++) {
    const bf16_t* Kc = Ks + (kt & 1) * (32 * ASTR);
    const bf16_t* Vc = Vs + (kt & 1) * (64 * VSTR);
    f32x16 s[2];
#pragma unroll
    for (int jt = 0; jt < 2; jt++) {
#pragma unroll
      for (int r = 0; r < 16; r++) s[jt][r] = 0.f;
#pragma unroll
      for (int ks = 0; ks < 6; ks++) {
        bf16x8 kf = *(const bf16x8*)(Kc + c31 * ASTR + ks * 16 + hf * 8);
        s[jt] = mfma32(kf, qf[jt][ks], s[jt]);
      }
    }
#pragma unroll
    for (int jt = 0; jt < 2; jt++) {
      float m0 = fmaxf(fmaxf(s[jt][0], s[jt][1]), fmaxf(s[jt][2], s[jt][3]));
      float m1 = fmaxf(fmaxf(s[jt][4], s[jt][5]), fmaxf(s[jt][6], s[jt][7]));
      float m2 = fmaxf(fmaxf(s[jt][8], s[jt][9]), fmaxf(s[jt][10], s[jt][11]));
      float m3 = fmaxf(fmaxf(s[jt][12], s[jt][13]), fmaxf(s[jt][14], s[jt][15]));
      const float mx = fmaxf(fmaxf(m0, m1), fmaxf(m2, m3));
      if (__any(mx > mrun[jt])) {
        const float mxa = fmaxf(mx, __shfl_xor(mx, 32));
        const float mnew = fmaxf(mrun[jt], mxa);
        const float alpha = __builtin_amdgcn_exp2f(mrun[jt] - mnew);
        mrun[jt] = mnew;
        lrun[jt] *= alpha;
#pragma unroll
        for (int dt = 0; dt < 2; dt++)
#pragma unroll
          for (int r = 0; r < 16; r++) o[dt][jt][r] *= alpha;
      }
      const float mcur = mrun[jt];
      float pv[16];
#pragma unroll
      for (int r = 0; r < 16; r++) pv[r] = __builtin_amdgcn_exp2f(s[jt][r] - mcur);
      lrun[jt] += (((pv[0] + pv[1]) + (pv[2] + pv[3])) + ((pv[4] + pv[5]) + (pv[6] + pv[7]))) +
                  (((pv[8] + pv[9]) + (pv[10] + pv[11])) + ((pv[12] + pv[13]) + (pv[14] + pv[15])));
      bf16x8 pf[2];
#pragma unroll
      for (int ss = 0; ss < 2; ss++) {
        uint4 u; u.x = pack2(pv[8 * ss + 0], pv[8 * ss + 1]); u.y = pack2(pv[8 * ss + 2], pv[8 * ss + 3]);
        u.z = pack2(pv[8 * ss + 4], pv[8 * ss + 5]); u.w = pack2(pv[8 * ss + 6], pv[8 * ss + 7]);
        pf[ss] = __builtin_bit_cast(bf16x8, u);
      }
#pragma unroll
      for (int dt = 0; dt < 2; dt++)
#pragma unroll
        for (int ss = 0; ss < 2; ss++) {
          uint2 lo = *(const uint2*)(Vc + (dt * 32 + c31) * VSTR + 16 * ss + 4 * hf);
          uint2 hi = *(const uint2*)(Vc + (dt * 32 + c31) * VSTR + 16 * ss + 8 + 4 * hf);
          uint4 u; u.x = lo.x; u.y = lo.y; u.z = hi.x; u.w = hi.y;
          o[dt][jt] = mfma32(__builtin_bit_cast(bf16x8, u), pf[ss], o[dt][jt]);
        }
    }
    if (kt + 1 < ntile) {
      bf16_t* Kn = Ks + ((kt + 1) & 1) * (32 * ASTR);
      bf16_t* Vn = Vs + ((kt + 1) & 1) * (64 * VSTR);
      *(u32x4*)(Kn + k0row * ASTR + k0cc * 8) = rk0;
      if (has_k1) *(u32x4*)(Kn + k1row * ASTR + k1cc * 8) = rk1;
      *(uint2*)(Vn + vrow * VSTR + vcc * 8) = make_uint2(rv0[0], rv0[1]);
      *(uint2*)(Vn + vrow * VSTR + vcc * 8 + 4) = make_uint2(rv0[2], rv0[3]);
      __syncthreads();
      if (kt + 2 < ntile) {
        rk0 = *(const u32x4*)(Kb + (size_t)((kt + 2) * 32 + k0row) * 96 + k0cc * 8);
        rk1 = *(const u32x4*)(Kb + (size_t)((kt + 2) * 32 + k1row) * 96 + k1cc * 8);
        rv0 = *(const u32x4*)(Vb + (size_t)vrow * 8448 + (kt + 2) * 32 + vcc * 8);
      }
    }
  }
  bf16_t* MIX = WSP(bf16_t, R_MIX);
#pragma unroll
  for (int jt = 0; jt < 2; jt++) {
    float l = lrun[jt];
    l += __shfl_xor(l, 32);
    const float inv = 1.f / l;
    const size_t row = out_row0 + w * 64 + jt * 32 + c31;
#pragma unroll
    for (int dt = 0; dt < 2; dt++)
#pragma unroll
      for (int g4 = 0; g4 < 4; g4++) {
        uint2 r; r.x = pack2(o[dt][jt][4 * g4 + 0] * inv, o[dt][jt][4 * g4 + 1] * inv); r.y = pack2(o[dt][jt][4 * g4 + 2] * inv, o[dt][jt][4 * g4 + 3] * inv);
        *(uint2*)(MIX + row * LDH + h * 64 + dt * 32 + 8 * g4 + 4 * hf) = r;
      }
  }
}
DEV void phase_attn(const Params& p, char* smem) {
  for (int item = blockIdx.x; item < 512 + 16; item += gridDim.x) attn_item(p, item, smem);
}

struct EpiRes {
  const float* xin_main; const float* xin_ctx; float* X; const float* mod;
  DEV void operator()(int m, int n, f32x4 v) {
    const float* src; int mr;
    if (m < MM) { src = xin_main + (size_t)m * 1024 + n; mr = m >> 13; } else { src = xin_ctx + (size_t)(m - MM) * 1024 + n; mr = 2; }
    float4 xo = *(const float4*)src;
    float4 g = *(const float4*)(mod + (size_t)mr * 6144 + 2048 + n);
    float4 r; r.x = xo.x + g.x * v[0]; r.y = xo.y + g.y * v[1]; r.z = xo.z + g.z * v[2]; r.w = xo.w + g.w * v[3];
    *(float4*)(X + (size_t)m * 1024 + n) = r;
  }
};
DEV void phase_gemm_out(const Params& p, int layer, char* smem) {
  float* X = WSP(float, OFF_X);
  EpiRes epi;
  epi.X = X; epi.mod = WSP(float, S_MOD) + (size_t)layer * 3 * 6144;
  const bf16_t* A; const bf16_t* Bt; int M;
  if (layer == 0) { epi.xin_main = p.in[I_X]; epi.xin_ctx = p.in[I_CTX]; A = WSP(bf16_t, R_MIX); Bt = WSP(bf16_t, S_WOUT0); M = MT; }
  else { epi.xin_main = X; epi.xin_ctx = X + (size_t)MM * 1024; A = WSP(bf16_t, OFF_H); Bt = WSP(bf16_t, S_WHGOUT); M = MM; }
  const int items = xcd_tile_items(M / 128, 8);
  for (int item = blockIdx.x; item < items; item += gridDim.x) {
    int mt, nt;
    if (!xcd_tile(item, M / 128, 8, mt, nt)) continue;
    gemm_tile(A, LDH, Bt, LDH, 1024, mt * 128, nt * 128, epi, smem);
  }
}

struct EpiBf {
  bf16_t* C; int ldc;
  DEV void operator()(int m, int n, f32x4 v) {
    uint2 r; r.x = pack2(v[0], v[1]); r.y = pack2(v[2], v[3]);
    *(uint2*)(C + (size_t)m * ldc + n) = r;
  }
};
DEV void phase_gemm_pq(const Params& p, int layer, int M, char* smem) {
  EpiBf epi{layer ? WSP(bf16_t, L1_PQ) : WSP(bf16_t, R_PQ), 2048};
  const bf16_t* Bt = WSP(bf16_t, S_WPQ) + (size_t)layer * 2048 * LDH;
  const int items = xcd_tile_items(M / 128, 16);
  for (int item = blockIdx.x; item < items; item += gridDim.x) {
    int mt, nt;
    if (!xcd_tile(item, M / 128, 16, mt, nt)) continue;
    gemm_tile(WSP(bf16_t, OFF_H), LDH, Bt, LDH, 1024, mt * 128, nt * 128, epi, smem);
  }
}

DEV void ce(float& a, float& b) { float hi = fmaxf(a, b), lo = fminf(a, b); a = hi; b = lo; }
DEV void bitonic16(float (&l)[16]) {
#pragma unroll
  for (int s = 8; s > 0; s >>= 1)
#pragma unroll
    for (int i = 0; i < 16; i++)
      if (!(i & s)) ce(l[i], l[i + s]);
}
DEV void sort16_desc(float (&a)[16]) {
#pragma unroll
  for (int k = 2; k <= 16; k <<= 1)
#pragma unroll
    for (int j = k >> 1; j > 0; j >>= 1)
#pragma unroll
      for (int i = 0; i < 16; i++) {
        const int p = i ^ j;
        if (p > i) { if ((i & k) == 0) ce(a[i], a[p]); else ce(a[p], a[i]); }
      }
}
DEV void merge_xor(float (&l)[16], int mask) {
  float t[16];
#pragma unroll
  for (int i = 0; i < 16; i++) t[i] = __shfl_xor(l[15 - i], mask);
#pragma unroll
  for (int i = 0; i < 16; i++) l[i] = fmaxf(l[i], t[i]);
  bitonic16(l);
}
DEV void peer_top16(const bf16_t* __restrict__ pq, const bf16_t* sk  , float (&l)[16]) {
  const int lane = tidx() & 63, l15 = lane & 15, quad = lane >> 4;
  f32x4 acc[8];
#pragma unroll
  for (int nt = 0; nt < 8; nt++) acc[nt] = (f32x4){0.f, 0.f, 0.f, 0.f};
#pragma unroll 1
  for (int ks = 0; ks < 4; ks++) {
    const bf16x8 bqk = *(const bf16x8*)(pq + ks * 32 + quad * 8);
#pragma unroll
    for (int nt = 0; nt < 8; nt++) {
      bf16x8 ak = *(const bf16x8*)(sk + (nt * 16 + l15) * 144 + ks * 32 + quad * 8);
      acc[nt] = mfma16(ak, bqk, acc[nt]);
    }
  }
  float hi[16];
#pragma unroll
  for (int nt = 0; nt < 4; nt++)
#pragma unroll
    for (int r = 0; r < 4; r++) {
      l[nt * 4 + r] = __uint_as_float((__float_as_uint(acc[nt][r]) & ~127u) | (unsigned)(nt * 16 + quad * 4 + r));
      hi[nt * 4 + r] = __uint_as_float((__float_as_uint(acc[nt + 4][r]) & ~127u) | (unsigned)((nt + 4) * 16 + quad * 4 + r));
    }
  sort16_desc(l);
  sort16_desc(hi);
#pragma unroll
  for (int i = 0; i < 16; i++) l[i] = fmaxf(l[i], hi[15 - i]);
  bitonic16(l);
  merge_xor(l, 16);
  merge_xor(l, 32);
}
DEV void phase_peer_score(const Params& p, int layer, int M, char* smem) {
  const bf16_t* PQ = layer ? WSP(bf16_t, L1_PQ) : WSP(bf16_t, R_PQ);
  int* EIDX = layer ? WSP(int, L1_EIDX) : WSP(int, R_EIDX);
  float* GATE = layer ? WSP(float, L1_GATE) : WSP(float, R_GATE);
  const bf16_t* SK = WSP(bf16_t, S_SUBK) + (size_t)layer * 16 * 128 * 128;
  const float* USC = WSP(float, S_UVSC) + (size_t)(layer * 2) * 16384;
  const int tid = tidx(), lane = tid & 63, w = tid >> 6, l15 = lane & 15, quad = lane >> 4;
  const int items = (M / 64) * 8;
  bf16_t* SKs = (bf16_t*)smem;
  int hcur = -1;
  for (int item = blockIdx.x; item < items; item += gridDim.x) {
    const int mtile = item >> 3, h = item & 7;
    if (h != hcur) {
      hcur = h;
      __syncthreads();
#pragma unroll
      for (int i = 0; i < 16; i++) {
        int id = tid + i * 256; int row = id >> 4, cc = id & 15;
        *(uint4*)(SKs + row * 144 + cc * 8) = *(const uint4*)(SK + ((size_t)h * 256 + row) * 128 + cc * 8);
      }
      __syncthreads();
    }
    const int m = mtile * 64 + w * 16 + l15;
    float L0[16], L1[16];
    peer_top16(PQ + (size_t)m * 2048 + h * 256, SKs, L0);
    peer_top16(PQ + (size_t)m * 2048 + h * 256 + 128, SKs + 128 * 144, L1);
    float R[16];
#pragma unroll
    for (int i = 0; i < 16; i++) R[i] = -3.0e38f;
#pragma unroll
    for (int i = 0; i < 16; i++)
#pragma unroll
      for (int j = 0; j < 16; j++)
        if ((i + 1) * (j + 1) <= 16) {
          float v = L0[i] + L1[j];
          v = __uint_as_float((__float_as_uint(v) & ~255u) | (unsigned)(i * 16 + j));
#pragma unroll
          for (int t = 0; t < 16; t++)
            if (t >= (i + 1) * (j + 1) - 1) ce(R[t], v);
        }
    unsigned char* tab = (unsigned char*)smem + 73728 + (w * 16 + l15) * 32;
#pragma unroll
    for (int i = 0; i < 16; i++) { tab[i] = (unsigned char)(__float_as_uint(L0[i]) & 127u); tab[16 + i] = (unsigned char)(__float_as_uint(L1[i]) & 127u); }
    float ev[16]; float sum = 0.f;
#pragma unroll
    for (int t = 0; t < 16; t++) { ev[t] = __expf(R[t] - R[0]); sum += ev[t]; }
    const float inv = 1.f / sum;
    int eid[16];
#pragma unroll
    for (int t = 0; t < 16; t++) {
      unsigned code = __float_as_uint(R[t]) & 255u;
      eid[t] = (int)tab[code >> 4] * 128 + (int)tab[16 + (code & 15u)];
    }
    if (quad == 0) {
      int* eo = EIDX + (size_t)m * 128 + h * 16;
      float* go = GATE + (size_t)m * 128 + h * 16;
      float* uo = go + (size_t)MT * 128;
      float us[16], vs[16];
#pragma unroll
      for (int t = 0; t < 16; t++) { us[t] = USC[eid[t]]; vs[t] = USC[16384 + eid[t]]; }
#pragma unroll
      for (int t = 0; t < 16; t += 4) {
        *(int4*)(eo + t) = make_int4(eid[t], eid[t + 1], eid[t + 2], eid[t + 3]);
        *(float4*)(go + t) = make_float4(ev[t] * inv * vs[t], ev[t + 1] * inv * vs[t + 1], ev[t + 2] * inv * vs[t + 2], ev[t + 3] * inv * vs[t + 3]);
        *(float4*)(uo + t) = make_float4(us[t], us[t + 1], us[t + 2], us[t + 3]);
      }
    }
  }
}

DEV f32x2 fp8dot4(unsigned u, f32x2 xa, f32x2 xb, f32x2 d) {
  d += __builtin_amdgcn_cvt_pk_f32_fp8((int)u, false) * xa;
  d += __builtin_amdgcn_cvt_pk_f32_fp8((int)u, true) * xb;
  return d;
}
DEV void phase_peer_expert(const Params& p, int layer, int M, bool final_, int part, char* smem) {
  const bf16_t* H = WSP(bf16_t, OFF_H);
  const int* EIDX = layer ? WSP(int, L1_EIDX) : WSP(int, R_EIDX);
  const float* GATE = layer ? WSP(float, L1_GATE) : WSP(float, R_GATE);
  const float* USEL = GATE + (size_t)MT * 128;
  const unsigned char* U = layer ? WSP(unsigned char, OFF_U1) : WSP(unsigned char, OFF_U0);
  const unsigned char* V = layer ? WSP(unsigned char, OFF_V1) : WSP(unsigned char, OFF_V0);
  float* X = WSP(float, OFF_X);
  float* COEF = layer ? WSP(float, L1_COEF) : WSP(float, R_COEF);
  const float* mod = WSP(float, S_MOD) + (size_t)layer * 3 * 6144;
  const int tid = tidx(), lane = tid & 63, w = tid >> 6, g = lane >> 4, l16 = lane & 15;
  int* se = (int*)smem + w * 512;
  float* sg = (float*)(se + 128);
  float* su = sg + 128;
  float* coefs = su + 128;
  if (part == 0) {
  for (int m = blockIdx.x * 4 + w; m < M; m += gridDim.x * 4) {
    {
      int2 e2 = *(const int2*)(EIDX + (size_t)m * 128 + lane * 2);
      float2 g2 = *(const float2*)(GATE + (size_t)m * 128 + lane * 2);
      float2 u2 = *(const float2*)(USEL + (size_t)m * 128 + lane * 2);
      *(int2*)(se + lane * 2) = e2; *(float2*)(sg + lane * 2) = g2; *(float2*)(su + lane * 2) = u2;
    }
    const bf16_t* hrow = H + (size_t)m * LDH + l16 * 16;
    f32x2 xf[32];
#pragma unroll
    for (int c = 0; c < 4; c++) {
      uint4 a = *(const uint4*)(hrow + c * 256), bq = *(const uint4*)(hrow + c * 256 + 8);
      xf[c * 8 + 0] = (f32x2){bflo(a.x), bfhi(a.x)}; xf[c * 8 + 1] = (f32x2){bflo(a.y), bfhi(a.y)};
      xf[c * 8 + 2] = (f32x2){bflo(a.z), bfhi(a.z)}; xf[c * 8 + 3] = (f32x2){bflo(a.w), bfhi(a.w)};
      xf[c * 8 + 4] = (f32x2){bflo(bq.x), bfhi(bq.x)}; xf[c * 8 + 5] = (f32x2){bflo(bq.y), bfhi(bq.y)};
      xf[c * 8 + 6] = (f32x2){bflo(bq.z), bfhi(bq.z)}; xf[c * 8 + 7] = (f32x2){bflo(bq.w), bfhi(bq.w)};
    }
    __syncthreads();
    u32x4 cur[8], nxt[8];
    {
      const unsigned char* r0p = U + (size_t)se[g] * 1024 + l16 * 16;
      const unsigned char* r1p = U + (size_t)se[4 + g] * 1024 + l16 * 16;
#pragma unroll
      for (int c = 0; c < 4; c++) { cur[c] = *(const u32x4*)(r0p + c * 256); cur[4 + c] = *(const u32x4*)(r1p + c * 256); }
    }
#pragma unroll 2
    for (int st = 0; st < 16; st++) {
      if (st + 1 < 16) {
        const unsigned char* r0p = U + (size_t)se[(st + 1) * 8 + g] * 1024 + l16 * 16;
        const unsigned char* r1p = U + (size_t)se[(st + 1) * 8 + 4 + g] * 1024 + l16 * 16;
#pragma unroll
        for (int c = 0; c < 4; c++) { nxt[c] = *(const u32x4*)(r0p + c * 256); nxt[4 + c] = *(const u32x4*)(r1p + c * 256); }
      }
      f32x2 da = (f32x2){0.f, 0.f}, db = (f32x2){0.f, 0.f};
#pragma unroll
      for (int c = 0; c < 4; c++) {
        da = fp8dot4(cur[c][0], xf[c * 8 + 0], xf[c * 8 + 1], da); da = fp8dot4(cur[c][1], xf[c * 8 + 2], xf[c * 8 + 3], da);
        da = fp8dot4(cur[c][2], xf[c * 8 + 4], xf[c * 8 + 5], da); da = fp8dot4(cur[c][3], xf[c * 8 + 6], xf[c * 8 + 7], da);
        db = fp8dot4(cur[4 + c][0], xf[c * 8 + 0], xf[c * 8 + 1], db); db = fp8dot4(cur[4 + c][1], xf[c * 8 + 2], xf[c * 8 + 3], db);
        db = fp8dot4(cur[4 + c][2], xf[c * 8 + 4], xf[c * 8 + 5], db); db = fp8dot4(cur[4 + c][3], xf[c * 8 + 6], xf[c * 8 + 7], db);
      }
      float d0 = da.x + da.y, d1 = db.x + db.y;
      d0 += __shfl_xor(d0, 1); d1 += __shfl_xor(d1, 1);
      d0 += __shfl_xor(d0, 2); d1 += __shfl_xor(d1, 2);
      d0 += __shfl_xor(d0, 4); d1 += __shfl_xor(d1, 4);
      d0 += __shfl_xor(d0, 8); d1 += __shfl_xor(d1, 8);
      const int s0 = st * 8 + g, s1 = s0 + 4;
      d0 *= su[s0]; d1 *= su[s1];
      const float a0 = 0.5f * d0 * (1.f + erff(d0 * 0.70710678118f));
      const float a1 = 0.5f * d1 * (1.f + erff(d1 * 0.70710678118f));
      if (l16 == 0) { COEF[(size_t)m * 128 + s0] = sg[s0] * a0; COEF[(size_t)m * 128 + s1] = sg[s1] * a1; }
#pragma unroll
      for (int c = 0; c < 8; c++) cur[c] = nxt[c];
    }
    __syncthreads();
  }
  return;
  }
  for (int m = blockIdx.x * 4 + w; m < M; m += gridDim.x * 4) {
    {
      int2 e2 = *(const int2*)(EIDX + (size_t)m * 128 + lane * 2);
      float2 c2 = *(const float2*)(COEF + (size_t)m * 128 + lane * 2);
      *(int2*)(se + lane * 2) = e2; *(float2*)(coefs + lane * 2) = c2;
    }
    u32x4 cur[8], nxt[8];
    __syncthreads();
    f32x2 acc[32];
#pragma unroll
    for (int i = 0; i < 32; i++) acc[i] = (f32x2){0.f, 0.f};
    {
      const unsigned char* r0p = V + (size_t)se[g] * 1024 + l16 * 16;
      const unsigned char* r1p = V + (size_t)se[4 + g] * 1024 + l16 * 16;
#pragma unroll
      for (int c = 0; c < 4; c++) { cur[c] = *(const u32x4*)(r0p + c * 256); cur[4 + c] = *(const u32x4*)(r1p + c * 256); }
    }
#pragma unroll 2
    for (int st = 0; st < 16; st++) {
      if (st + 1 < 16) {
        const unsigned char* r0p = V + (size_t)se[(st + 1) * 8 + g] * 1024 + l16 * 16;
        const unsigned char* r1p = V + (size_t)se[(st + 1) * 8 + 4 + g] * 1024 + l16 * 16;
#pragma unroll
        for (int c = 0; c < 4; c++) { nxt[c] = *(const u32x4*)(r0p + c * 256); nxt[4 + c] = *(const u32x4*)(r1p + c * 256); }
      }
      const float c0 = coefs[st * 8 + g], c1 = coefs[st * 8 + 4 + g];
      const f32x2 ca = (f32x2){c0, c0}, cb = (f32x2){c1, c1};
#pragma unroll
      for (int c = 0; c < 4; c++) {
#pragma unroll
        for (int d = 0; d < 4; d++) {
          acc[c * 8 + d * 2 + 0] += ca * __builtin_amdgcn_cvt_pk_f32_fp8((int)cur[c][d], false);
          acc[c * 8 + d * 2 + 1] += ca * __builtin_amdgcn_cvt_pk_f32_fp8((int)cur[c][d], true);
          acc[c * 8 + d * 2 + 0] += cb * __builtin_amdgcn_cvt_pk_f32_fp8((int)cur[4 + c][d], false);
          acc[c * 8 + d * 2 + 1] += cb * __builtin_amdgcn_cvt_pk_f32_fp8((int)cur[4 + c][d], true);
        }
      }
#pragma unroll
      for (int c = 0; c < 8; c++) cur[c] = nxt[c];
    }
    __syncthreads();
#pragma unroll
    for (int i = 0; i < 32; i++) {
      acc[i].x += __shfl_xor(acc[i].x, 16); acc[i].x += __shfl_xor(acc[i].x, 32);
      acc[i].y += __shfl_xor(acc[i].y, 16); acc[i].y += __shfl_xor(acc[i].y, 32);
    }
    const int mr = (m < MM) ? (m >> 13) : 2;
    const float* m5 = mod + (size_t)mr * 6144 + 5 * 1024;
    float xn[16];
#pragma unroll
    for (int c = 0; c < 4; c++) {
      if (c == g) {
#pragma unroll
        for (int i = 0; i < 8; i++) { xn[2 * i] = acc[c * 8 + i].x; xn[2 * i + 1] = acc[c * 8 + i].y; }
      }
    }
    const int col = g * 256 + l16 * 16;
    float ss = 0.f;
#pragma unroll
    for (int q = 0; q < 4; q++) {
      float4 xa = *(const float4*)(X + (size_t)m * 1024 + col + q * 4);
      float4 ma = *(const float4*)(m5 + col + q * 4);
      xn[q * 4 + 0] = xa.x + ma.x * xn[q * 4 + 0]; xn[q * 4 + 1] = xa.y + ma.y * xn[q * 4 + 1];
      xn[q * 4 + 2] = xa.z + ma.z * xn[q * 4 + 2]; xn[q * 4 + 3] = xa.w + ma.w * xn[q * 4 + 3];
    }
#pragma unroll
    for (int i = 0; i < 16; i++) ss += xn[i] * xn[i];
    if (!final_) {
#pragma unroll
      for (int q = 0; q < 4; q++)
        *(float4*)(X + (size_t)m * 1024 + col + q * 4) = make_float4(xn[q * 4 + 0], xn[q * 4 + 1], xn[q * 4 + 2], xn[q * 4 + 3]);
      ss = wave_sum(ss);
      const float rinv = rsqrtf(ss * (1.f / 1024.f) + 1e-6f);
      const float* ng = p.in[I_N1G] + (layer + 1) * 1024;
      const float* nmod = WSP(float, S_MOD) + (size_t)(layer + 1) * 3 * 6144 + (size_t)mr * 6144;
      unsigned hv[8];
#pragma unroll
      for (int q = 0; q < 4; q++) {
        float4 g4 = *(const float4*)(ng + col + q * 4), sh = *(const float4*)(nmod + col + q * 4), sc = *(const float4*)(nmod + 1024 + col + q * 4);
        hv[q * 2 + 0] = pack2(xn[q * 4 + 0] * rinv * g4.x * (1.f + sc.x) + sh.x, xn[q * 4 + 1] * rinv * g4.y * (1.f + sc.y) + sh.y);
        hv[q * 2 + 1] = pack2(xn[q * 4 + 2] * rinv * g4.z * (1.f + sc.z) + sh.z, xn[q * 4 + 3] * rinv * g4.w * (1.f + sc.w) + sh.w);
      }
      bf16_t* hw = WSP(bf16_t, OFF_H) + (size_t)m * LDH + col;
      *(uint4*)(hw) = make_uint4(hv[0], hv[1], hv[2], hv[3]);
      *(uint4*)(hw + 8) = make_uint4(hv[4], hv[5], hv[6], hv[7]);
    } else {
      ss = wave_sum(ss);
      const float rinv = rsqrtf(ss * (1.f / 1024.f) + 1e-6f);
      const float* fg = p.in[I_FNG];
#pragma unroll
      for (int q = 0; q < 4; q++) {
        float4 g4 = *(const float4*)(fg + col + q * 4);
        *(float4*)(p.out + (size_t)m * 1024 + col + q * 4) = make_float4(xn[q * 4 + 0] * rinv * g4.x, xn[q * 4 + 1] * rinv * g4.y, xn[q * 4 + 2] * rinv * g4.z, xn[q * 4 + 3] * rinv * g4.w);
      }
    }
  }
}

struct EpiHG {
  bf16_t* QH; bf16_t* LF; bf16_t* LB; bf16_t* IH; bf16_t* GH; const float* lbp;
  DEV void operator()(int m, int n, f32x4 v) {
    const int seg = n >> 10, c = n & 1023;
    bf16_t* dst;
    if (seg == 0) dst = QH; else if (seg == 1) dst = LF; else if (seg == 2) dst = LB; else if (seg == 3) dst = IH; else dst = GH;
    if (seg == 1 || seg == 2) {
      const int dir = seg - 1;
#pragma unroll
      for (int r = 0; r < 4; r++) {
        float lb = sigm(lbp[(2 + dir) * 1024 + c + r] - lbp[dir * 1024 + c + r]);
        float ff = lb + (1.f - lb) * sigm(v[r]);
        v[r] = __logf(ff);
      }
    }
    uint2 o; o.x = pack2(v[0], v[1]); o.y = pack2(v[2], v[3]);
    *(uint2*)(dst + (size_t)m * 1024 + c) = o;
  }
};
DEV void phase_gemm_hgin(const Params& p, char* smem) {
  EpiHG epi{WSP(bf16_t, L1_QH), WSP(bf16_t, L1_LF), WSP(bf16_t, L1_LB), WSP(bf16_t, L1_IH), WSP(bf16_t, L1_GH), p.in[I_HGLB]};
  const int items = (MT / 128) * 40;
  for (int item = blockIdx.x; item < items; item += gridDim.x) {
    int mt = item / 40, nt = item - mt * 40;
    gemm_tile(WSP(bf16_t, OFF_H), LDH, WSP(bf16_t, S_WHGIN), LDH, 1024, mt * 128, nt * 128, epi, smem);
  }
}

DEV int hg_row0(int cidx, int b) { return (cidx < 4) ? (MM + b * 256 + cidx * 64) : (b * 8192 + (cidx - 4) * 64); }
DEV int hg_step(int cidx, int dir) {
  if (dir == 0) return cidx;
  return (cidx < 4) ? (3 - cidx) : (4 + 127 - (cidx - 4));
}

DEV void phase_hg_c1(const Params& p, char* smem) {
  const bf16_t* LFp = WSP(bf16_t, L1_LF); const bf16_t* LBp = WSP(bf16_t, L1_LB); const bf16_t* IH = WSP(bf16_t, L1_IH);
  bf16_t* DS = WSP(bf16_t, L1_DS); float* DEC = WSP(float, S_DECAY);
  bf16_t* RA = (bf16_t*)smem;
  bf16_t* RB = RA + 128 * 80;
  bf16_t* Vt = RB + 128 * 80;
  float* tot = (float*)(Vt + 128 * 80);
  const int tid = tidx(), lane = tid & 63, w = tid >> 6, l15 = lane & 15, quad = lane >> 4;
  const int wm = w >> 1, wn = w & 1;
  const int k = tid & 127, half = tid >> 7;
  const int items = 132 * 16;
  for (int item = blockIdx.x; item < items; item += gridDim.x) {
    const int cidx = item >> 4, bh = item & 15, b = bh >> 3, h = bh & 7;
    const int r0 = hg_row0(cidx, b);
    __syncthreads();
#pragma unroll
    for (int i = 0; i < 4; i++) {
      int id = tid + i * 256; int s = id >> 4, cc = id & 15;
      uint4 u = *(const uint4*)(IH + (size_t)(r0 + s) * 1024 + h * 128 + cc * 8);
      uint4 lf = *(const uint4*)(LFp + (size_t)(r0 + s) * 1024 + h * 128 + cc * 8);
      *(uint4*)(RB + s * 144 + cc * 8) = lf;
      bf16_t* vt = Vt + (cc * 8) * 80 + s;
      vt[0] = (bf16_t)(u.x & 0xffff); vt[80] = (bf16_t)(u.x >> 16); vt[160] = (bf16_t)(u.y & 0xffff); vt[240] = (bf16_t)(u.y >> 16);
      vt[320] = (bf16_t)(u.z & 0xffff); vt[400] = (bf16_t)(u.z >> 16); vt[480] = (bf16_t)(u.w & 0xffff); vt[560] = (bf16_t)(u.w >> 16);
    }
#pragma unroll 1
    for (int dir = 0; dir < 2; dir++) {
      bf16_t* stg = dir ? RA : RB;
      bf16_t* kot = dir ? RB : RA;
      if (dir == 1) {
        __syncthreads();
#pragma unroll
        for (int i = 0; i < 4; i++) {
          int id = tid + i * 256; int s = id >> 4, cc = id & 15;
          *(uint4*)(RA + s * 144 + cc * 8) = *(const uint4*)(LBp + (size_t)(r0 + s) * 1024 + h * 128 + cc * 8);
        }
      }
      __syncthreads();
      {
        float t = 0.f;
#pragma unroll 8
        for (int s = 0; s < 32; s++) t += bf2f(stg[(half * 32 + s) * 144 + k]);
        tot[half * 128 + k] = t;
      }
      __syncthreads();
      {
        const float tot0 = tot[k], total = tot0 + tot[128 + k];
        float run = half ? tot0 : 0.f;
        float lfr[32];
#pragma unroll
        for (int s = 0; s < 32; s++) lfr[s] = bf2f(stg[(half * 32 + s) * 144 + k]);
        if (dir == 1) __syncthreads();
        bf16_t* ko = kot + k * 80 + half * 32;
#pragma unroll
        for (int s2 = 0; s2 < 32; s2 += 2) {
          float o2[2];
#pragma unroll
          for (int u = 0; u < 2; u++) {
            const float lf = lfr[s2 + u];
            const float kk = 1.f - __expf(lf);
            float ex;
            if (dir == 0) { run += lf; ex = total - run; } else { ex = run; run += lf; }
            o2[u] = kk * __expf(ex);
          }
          *(unsigned*)(ko + s2) = pack2(o2[0], o2[1]);
        }
        if (half == 0) DEC[((size_t)(bh * 2 + dir) * 132 + hg_step(cidx, dir)) * 128 + k] = __expf(total);
      }
      __syncthreads();
      f32x4 acc[4][4];
#pragma unroll
      for (int i = 0; i < 4; i++)
#pragma unroll
        for (int j = 0; j < 4; j++) acc[i][j] = (f32x4){0.f, 0.f, 0.f, 0.f};
      mfma_lds<4, 4, 2>(kot, 80, Vt, 80, wm * 64, wn * 64, acc);
      bf16_t* dst = DS + ((size_t)(bh * 2 + dir) * 132 + hg_step(cidx, dir)) * 16384;
#pragma unroll
      for (int i = 0; i < 4; i++)
#pragma unroll
        for (int j = 0; j < 4; j++) {
          int kk = wm * 64 + i * 16 + quad * 4, dv = wn * 64 + j * 16 + l15;
          uint2 o; o.x = pack2(acc[i][j][0], acc[i][j][1]); o.y = pack2(acc[i][j][2], acc[i][j][3]);
          *(uint2*)(dst + dv * 128 + kk) = o;
        }
    }
  }
}

DEV void phase_hg_c2(const Params& p) {
  bf16_t* DS = WSP(bf16_t, L1_DS); const float* DEC = WSP(float, S_DECAY);
  for (int idx = blockIdx.x * 256 + tidx(); idx < 32 * 128 * 32; idx += gridDim.x * 256) {
    const int k4 = idx & 31, dv = (idx >> 5) & 127, chain = idx >> 12;
    bf16_t* dp = DS + (size_t)chain * 132 * 16384 + dv * 128 + k4 * 4;
    const float* dc = DEC + (size_t)chain * 132 * 128 + k4 * 4;
    float s0 = 0.f, s1 = 0.f, s2 = 0.f, s3 = 0.f;
    for (int st = 0; st < 132; st += 4) {
      uint2 d[4]; float4 dd[4];
#pragma unroll
      for (int u = 0; u < 4; u++) { d[u] = *(const uint2*)(dp + (size_t)(st + u) * 16384); dd[u] = *(const float4*)(dc + (size_t)(st + u) * 128); }
#pragma unroll
      for (int u = 0; u < 4; u++) {
        uint2 o; o.x = pack2(s0, s1); o.y = pack2(s2, s3);
        *(uint2*)(dp + (size_t)(st + u) * 16384) = o;
        s0 = dd[u].x * s0 + bflo(d[u].x); s1 = dd[u].y * s1 + bfhi(d[u].x);
        s2 = dd[u].z * s2 + bflo(d[u].y); s3 = dd[u].w * s3 + bfhi(d[u].y);
      }
    }
  }
}

DEV void phase_hg_c3(const Params& p, char* smem) {
  const bf16_t* QH = WSP(bf16_t, L1_QH); const bf16_t* LFp = WSP(bf16_t, L1_LF); const bf16_t* LBp = WSP(bf16_t, L1_LB);
  const bf16_t* IH = WSP(bf16_t, L1_IH); const bf16_t* GH = WSP(bf16_t, L1_GH); const bf16_t* DS = WSP(bf16_t, L1_DS);
  bf16_t* Rout = WSP(bf16_t, OFF_H);
  bf16_t* Qin = (bf16_t*)smem;
  bf16_t* Kin = Qin + 64 * 144;
  bf16_t* Vt = Kin + 64 * 144;
  bf16_t* Am = Vt + 128 * 80;
  bf16_t* SpT = Kin;
  float* Ob = (float*)smem;
  float* tot = (float*)(Am);
  const int tid = tidx(), lane = tid & 63, w = tid >> 6, l15 = lane & 15, quad = lane >> 4;
  const int wm = w >> 1, wn = w & 1;
  const int items = 128 * 16;
  for (int item = blockIdx.x; item < items; item += gridDim.x) {
    const int c = item >> 4, bh = item & 15, b = bh >> 3, h = bh & 7;
    const int cidx = c + 4;
    const int r0 = b * 8192 + c * 64;
    f32x4 acc[2][4];
#pragma unroll
    for (int i = 0; i < 2; i++)
#pragma unroll
      for (int j = 0; j < 4; j++) acc[i][j] = (f32x4){0.f, 0.f, 0.f, 0.f};
#pragma unroll 1
    for (int dir = 0; dir < 2; dir++) {
      __syncthreads();
      const int k = tid & 127, half = tid >> 7;
      {
        const bf16_t* lsrc = (dir ? LBp : LFp);
#pragma unroll
        for (int i = 0; i < 4; i++) {
          int id = tid + i * 256; int s = id >> 4, cc = id & 15;
          const size_t go = (size_t)(r0 + s) * 1024 + h * 128 + cc * 8;
          uint4 u = *(const uint4*)(IH + go);
          *(uint4*)(Kin + s * 144 + cc * 8) = *(const uint4*)(lsrc + go);
          *(uint4*)(Qin + s * 144 + cc * 8) = *(const uint4*)(QH + go);
          bf16_t* vt = Vt + (cc * 8) * 80 + s;
          vt[0] = (bf16_t)(u.x & 0xffff); vt[80] = (bf16_t)(u.x >> 16); vt[160] = (bf16_t)(u.y & 0xffff); vt[240] = (bf16_t)(u.y >> 16);
          vt[320] = (bf16_t)(u.z & 0xffff); vt[400] = (bf16_t)(u.z >> 16); vt[480] = (bf16_t)(u.w & 0xffff); vt[560] = (bf16_t)(u.w >> 16);
        }
      }
      u32x4 spr[8];
      {
        const bf16_t* sp = DS + ((size_t)(bh * 2 + dir) * 132 + hg_step(cidx, dir)) * 16384;
#pragma unroll
        for (int i = 0; i < 8; i++) { int id = tid + i * 256; int row = id >> 4, cc = id & 15; spr[i] = *(const u32x4*)(sp + row * 128 + cc * 8); }
      }
      __syncthreads();
      {
        float t = 0.f;
#pragma unroll 8
        for (int s = 0; s < 32; s++) t += bf2f(Kin[(half * 32 + s) * 144 + k]);
        tot[half * 128 + k] = t;
      }
      __syncthreads();
      if (dir == 0) {
        float run = half ? tot[k] : 0.f;
#pragma unroll 4
        for (int s = 0; s < 32; s++) {
          const int t = half * 32 + s;
          const float lf = bf2f(Kin[t * 144 + k]); run += lf;
          const float q = bf2f(Qin[t * 144 + k]);
          Qin[t * 144 + k] = f2bf(q * __expf(run));
          Kin[t * 144 + k] = f2bf((1.f - __expf(lf)) * __expf(-run));
        }
      } else {
        float run = half ? 0.f : tot[128 + k];
#pragma unroll 4
        for (int s = 31; s >= 0; s--) {
          const int t = half * 32 + s;
          const float lf = bf2f(Kin[t * 144 + k]); run += lf;
          const float q = bf2f(Qin[t * 144 + k]);
          Qin[t * 144 + k] = f2bf(q * __expf(run));
          Kin[t * 144 + k] = f2bf((1.f - __expf(lf)) * __expf(-run));
        }
      }
      __syncthreads();
      {
        f32x4 aa[2][2];
#pragma unroll
        for (int i = 0; i < 2; i++) { aa[i][0] = (f32x4){0.f, 0.f, 0.f, 0.f}; aa[i][1] = (f32x4){0.f, 0.f, 0.f, 0.f}; }
        mfma_lds<2, 2, 4>(Qin, 144, Kin, 144, wm * 32, wn * 32, aa);
#pragma unroll
        for (int i = 0; i < 2; i++)
#pragma unroll
          for (int j = 0; j < 2; j++)
#pragma unroll
            for (int r = 0; r < 4; r++) {
              int t = wm * 32 + i * 16 + quad * 4 + r, s = wn * 32 + j * 16 + l15;
              bool keep = dir ? (s >= t) : (s <= t);
              Am[t * 80 + s] = f2bf(keep ? aa[i][j][r] : 0.f);
            }
      }
      __syncthreads();
      mfma_lds<2, 4, 2>(Am, 80, Vt, 80, wm * 32, wn * 64, acc);
      __syncthreads();
#pragma unroll
      for (int i = 0; i < 8; i++) { int id = tid + i * 256; int row = id >> 4, cc = id & 15; *(u32x4*)(SpT + row * 144 + cc * 8) = spr[i]; }
      __syncthreads();
      mfma_lds<2, 4, 4>(Qin, 144, SpT, 144, wm * 32, wn * 64, acc);
    }
    __syncthreads();
#pragma unroll
    for (int i = 0; i < 2; i++)
#pragma unroll
      for (int j = 0; j < 4; j++)
#pragma unroll
        for (int r = 0; r < 4; r++) Ob[(wm * 32 + i * 16 + quad * 4 + r) * 132 + wn * 64 + j * 16 + l15] = acc[i][j][r];
    __syncthreads();
    {
      const int t = tid >> 2, q4 = tid & 3;
      float vals[32]; float ss = 0.f;
#pragma unroll
      for (int j = 0; j < 4; j++) {
        const int dv = (j * 4 + q4) * 8;
        float4 a = *(const float4*)(Ob + t * 132 + dv), bq = *(const float4*)(Ob + t * 132 + dv + 4);
        vals[j * 8 + 0] = a.x; vals[j * 8 + 1] = a.y; vals[j * 8 + 2] = a.z; vals[j * 8 + 3] = a.w;
        vals[j * 8 + 4] = bq.x; vals[j * 8 + 5] = bq.y; vals[j * 8 + 6] = bq.z; vals[j * 8 + 7] = bq.w;
      }
#pragma unroll
      for (int i = 0; i < 32; i++) ss += vals[i] * vals[i];
      ss += __shfl_xor(ss, 1); ss += __shfl_xor(ss, 2);
      const float rinv = rsqrtf(ss * (1.f / 128.f) + 1e-6f);
      const float* ng = p.in[I_HGNG];
#pragma unroll
      for (int j = 0; j < 4; j++) {
        const int col = h * 128 + (j * 4 + q4) * 8;
        uint4 gu = *(const uint4*)(GH + (size_t)(r0 + t) * 1024 + col);
        float4 na = *(const float4*)(ng + col), nb = *(const float4*)(ng + col + 4);
        float g0 = bflo(gu.x), g1 = bfhi(gu.x), g2 = bflo(gu.y), g3 = bfhi(gu.y), g4 = bflo(gu.z), g5 = bfhi(gu.z), g6 = bflo(gu.w), g7 = bfhi(gu.w);
        uint4 o;
        o.x = pack2(vals[j * 8 + 0] * rinv * na.x * g0 * sigm(g0), vals[j * 8 + 1] * rinv * na.y * g1 * sigm(g1));
        o.y = pack2(vals[j * 8 + 2] * rinv * na.z * g2 * sigm(g2), vals[j * 8 + 3] * rinv * na.w * g3 * sigm(g3));
        o.z = pack2(vals[j * 8 + 4] * rinv * nb.x * g4 * sigm(g4), vals[j * 8 + 5] * rinv * nb.y * g5 * sigm(g5));
        o.w = pack2(vals[j * 8 + 6] * rinv * nb.z * g6 * sigm(g6), vals[j * 8 + 7] * rinv * nb.w * g7 * sigm(g7));
        *(uint4*)(Rout + (size_t)(r0 + t) * LDH + col) = o;
      }
    }
  }
}


#define XB_TMO      128
#define XB_XCNT(j)  (256  + 64 * (j))
#define XB_XSUB(j)  (1280 + 64 * (j))
#define XB_XGEN(j)  (2304 + 64 * (j))
#define XB_TOP      3328
#define XB_TOPGEN   3392
#define XCD_BAR_WORDS 3456
#define XB_SPIN_CAP (1u << 22)
#define LAS __attribute__((address_space(3)))
DEV unsigned xb_ld(unsigned* p) { return __hip_atomic_load(p, __ATOMIC_RELAXED, __HIP_MEMORY_SCOPE_AGENT); }
DEV unsigned xb_add(unsigned* p, unsigned v) { return __hip_atomic_fetch_add(p, v, __ATOMIC_RELAXED, __HIP_MEMORY_SCOPE_AGENT); }
DEV unsigned xb_xcc_id() { return (unsigned)__builtin_amdgcn_s_getreg((3 << 11) | 20) & 0xFu; }
#define XB_SPIN(cond, bar) do { unsigned _sp = 0; while (cond) { __builtin_amdgcn_s_sleep(1); \
    if ((++_sp & 255u) == 0u) { if (xb_ld(&(bar)[XB_TMO])) break; if (_sp > XB_SPIN_CAP) { atomicAdd(&(bar)[XB_TMO], 1u); break; } } } } while (0)
struct XcdBarrier { unsigned* bar; unsigned x; volatile LAS unsigned* st; };
DEV XcdBarrier xcd_barrier_post(unsigned* bar, volatile LAS unsigned* st) {
  XcdBarrier b; b.bar = bar; b.x = xb_xcc_id(); b.st = st;
  if (threadIdx.x == 0) (void)xb_add(&bar[XB_XCNT(b.x)], 1u);
  return b;
}
DEV void xcd_barrier_complete(unsigned* bar, unsigned x, unsigned& nloc, unsigned& nx) {
  const unsigned G = gridDim.x * gridDim.y * gridDim.z;
  unsigned sum, cnt, mine, sp = 0u;
  for (;;) {
    sum = 0u; cnt = 0u; mine = 0u;
#pragma unroll
    for (unsigned j = 0; j < 16; ++j) { const unsigned c = xb_ld(&bar[XB_XCNT(j)]); sum += c; cnt += (c > 0u) ? 1u : 0u; mine = (j == x) ? c : mine; }
    if (sum == G) break;
    __builtin_amdgcn_s_sleep(1);
    if ((++sp & 255u) == 0u) { if (xb_ld(&bar[XB_TMO])) break; if (sp > XB_SPIN_CAP) { atomicAdd(&bar[XB_TMO], 1u); break; } }
  }
  nloc = mine > 0u ? mine : 1u; nx = cnt > 0u ? cnt : 1u;
}
DEV void xcd_barrier(const XcdBarrier& b) {
  asm volatile("s_waitcnt vmcnt(0)" ::: "memory");
  __syncthreads();
  if (threadIdx.x == 0) {
    unsigned* bar = b.bar;
    __builtin_amdgcn_s_waitcnt(0);
    unsigned nloc = b.st[0], nx = b.st[1];
    if (nloc == 0u) { xcd_barrier_complete(bar, b.x, nloc, nx); b.st[0] = nloc; b.st[1] = nx; }
    const unsigned old = xb_add(&bar[XB_XSUB(b.x)], 1u);
    const unsigned gen = old / nloc;
    if (old + 1u == (gen + 1u) * nloc) {
      __builtin_amdgcn_fence(__ATOMIC_RELEASE, "agent");
      asm volatile("s_waitcnt vmcnt(0)" ::: "memory");
      const unsigned og = xb_add(&bar[XB_TOP], 1u);
      const unsigned tg = og / nx;
      if (og + 1u == (tg + 1u) * nx) xb_add(&bar[XB_TOPGEN], 1u);
      else XB_SPIN(xb_ld(&bar[XB_TOPGEN]) == tg, bar);
      __builtin_amdgcn_fence(__ATOMIC_ACQUIRE, "agent");
      xb_add(&bar[XB_XGEN(b.x)], 1u);
      asm volatile("s_waitcnt vmcnt(0)" ::: "memory");
    } else {
      XB_SPIN(xb_ld(&bar[XB_XGEN(b.x)]) == gen, bar);
      __builtin_amdgcn_fence(__ATOMIC_ACQUIRE, "agent");
      asm volatile("s_waitcnt vmcnt(0)" ::: "memory");
    }
  }
  __syncthreads();
}

#define NPHASE 21
#define SMEM_BYTES 80896
#define TAB_OFF 80640
DEV void park_params(const Params& p, char* smem) {
  if (tidx() == 0) {
    unsigned long long* tab = (unsigned long long*)(smem + TAB_OFF);
#pragma unroll
    for (int i = 0; i < 27; i++) tab[i] = (unsigned long long)p.in[i];
    tab[27] = (unsigned long long)p.ws;
    tab[28] = (unsigned long long)p.out;
  }
  __syncthreads();
}
DEV unsigned long long tab_get(const char* smem, int i) {
  const unsigned* t = (const unsigned*)(smem + TAB_OFF) + 2 * i;
  unsigned lo = __builtin_amdgcn_readfirstlane(t[0]), hi = __builtin_amdgcn_readfirstlane(t[1]);
  return ((unsigned long long)hi << 32) | lo;
}
typedef __attribute__((address_space(1))) char gchar_t;
DEV void fetch_params(Params& q, const char* smem) {
#pragma unroll
  for (int i = 0; i < 27; i++) q.in[i] = (const float*)(char*)(gchar_t*)tab_get(smem, i);
  q.ws = (char*)(gchar_t*)tab_get(smem, 27);
  q.out = (float*)(char*)(gchar_t*)tab_get(smem, 28);
}
DEV void run_phase(int ph, char* smem) {
#ifdef ONLYPH
  if (ph != ONLYPH) return;
#endif
  Params p;
  fetch_params(p, smem);
  switch (ph) {
    case 0: phase_prep(p, smem); break;
    case 1: phase_norm(p, 0, 0, MT, true); break;
    case 2: phase_gemm_win(p, smem); break;
    case 3: phase_post1(p); break;
    case 4: phase_qkv_conv(p, smem); break;
    case 5: phase_attn(p, smem); break;
    case 6: phase_gemm_out(p, 0, smem); break;
    case 7: phase_norm(p, 0, 1, MT, false); break;
    case 8: phase_gemm_pq(p, 0, MT, smem); break;
    case 9: phase_peer_score(p, 0, MT, smem); break;
    case 10: phase_peer_expert(p, 0, MT, false, 1, smem); break;
    case 110: phase_peer_expert(p, 0, MT, false, 0, smem); break;
    case 11: break;
    case 12: phase_gemm_hgin(p, smem); break;
    case 13: phase_hg_c1(p, smem); break;
    case 14: phase_hg_c2(p); break;
    case 15: phase_hg_c3(p, smem); break;
    case 16: phase_gemm_out(p, 1, smem); break;
    case 17: phase_norm(p, 1, 1, MM, false); break;
    case 18: phase_gemm_pq(p, 1, MM, smem); break;
    case 19: phase_peer_score(p, 1, MM, smem); break;
    case 20: phase_peer_expert(p, 1, MM, true, 1, smem); break;
    case 120: phase_peer_expert(p, 1, MM, true, 0, smem); break;
    default: break;
  }
}

#if MEGA
#define OFF_BAR (492 * MIB)
__global__ void __launch_bounds__(256, 2) fwd_megakernel(Params p) {
  __shared__ __attribute__((aligned(16))) char smem[SMEM_BYTES];
  __shared__ uint4 xb_words;
  cg::grid_group grid = cg::this_grid();
  if (threadIdx.x == 0) xb_words = make_uint4(0u, 0u, 0u, 0u);
  park_params(p, smem);
  XcdBarrier xb = xcd_barrier_post((unsigned*)(p.ws + OFF_BAR), (volatile LAS unsigned*)&xb_words);
#pragma unroll 1
  for (int ph = 0; ph < NPHASE; ph++) {
    if (ph == 11) continue;
    if (ph == 10 || ph == 20) { run_phase(ph + 100, smem); xcd_barrier(xb); }
    run_phase(ph, smem);
    if (ph + 1 < NPHASE) xcd_barrier(xb);
    if (p.ws == nullptr) grid.sync();
  }
}
#else
__global__ void __launch_bounds__(256, 2) fwd_phase(Params p, int ph) {
  __shared__ __attribute__((aligned(16))) char smem[SMEM_BYTES];
  park_params(p, smem);
  run_phase(ph, smem);
}
#endif

extern "C" void kernel_launch(void* const* d_in, const int* in_sizes, int n_in, void* d_out, int out_size, void* d_ws,
                              size_t ws_size, hipStream_t stream) {
  Params p{};
  for (int i = 0; i < 27; i++) p.in[i] = (const float*)d_in[i];
  p.ws = (char*)d_ws;
  p.out = (float*)d_out;
  if (ws_size < WS_NEED) { fprintf(stderr, "workspace too small: %zu\n", ws_size); return; }
#if MEGA
  static int grid_blocks = 0;
  if (!grid_blocks) {
    int dev = 0, cus = 0, per_cu = 0;
    hipGetDevice(&dev);
    hipDeviceGetAttribute(&cus, hipDeviceAttributeMultiprocessorCount, dev);
    hipOccupancyMaxActiveBlocksPerMultiprocessor(&per_cu, fwd_megakernel, 256, 0);
    if (per_cu > 2) per_cu = 2;
    grid_blocks = cus * per_cu;
  }
  hipMemsetAsync((char*)d_ws + OFF_BAR, 0, XCD_BAR_WORDS * 4, stream);
  void* args[] = {&p};
  hipError_t e = hipLaunchCooperativeKernel((void*)fwd_megakernel, dim3(grid_blocks), dim3(256), args, 0, stream);
  if (e != hipSuccess) fprintf(stderr, "cooperative launch failed: %s (grid %d)\n", hipGetErrorString(e), grid_blocks);
#else
  for (int ph = 0; ph < NPHASE; ph++) fwd_phase<<<dim3(1024), dim3(256), 0, stream>>>(p, ph);
#endif
}
```
